# Optimizing an MI355X kernel written in HIP

```python
import math
import jax, jax.numpy as jnp
from jax import lax
import numpy as np

D_MODEL = 1024
BATCH = 2
SEQ = 16384
DEPTH = 2
DEC_BATCH = 8
DEC_SEQ = 16
PAST_LEN = 2048

CHUNK = 64
MLP_CHUNK = 128
N_HEADS_A = 4
HEAD_A = D_MODEL // 16
W_A = N_HEADS_A * HEAD_A
W_B = D_MODEL // 4
CONV_W = 31
N_HEADS_C = 8
QK_NOPE = 64
QK_ROPE = 32
V_DIM = 64
W_C = N_HEADS_C * V_DIM
Q_LORA = 384
KV_LORA = 256
ROPE_THETA = 10000.0
Q_BLOCK = 128
ATTN_SCALE = (QK_NOPE + QK_ROPE) ** -0.5
D_MIX = W_A + W_B + W_C
_COLS = (W_A, W_A, W_A, 2 * W_B, W_B, Q_LORA, KV_LORA, QK_ROPE, W_C)
D_IN = sum(_COLS)
SPLIT_POINTS = tuple(sum(_COLS[: i + 1]) for i in range(len(_COLS) - 1))
ALPHA = (2 * DEPTH) ** 0.25
BETA = (8 * DEPTH) ** -0.25
LN_EPS = 1e-5
RMS_EPS = 1e-6

kernel_name = "hybrid_streaming_encoder_step"


def _layernorm(x, g=None, b=None):
    xf = x.astype(jnp.float32)
    mu = jnp.mean(xf, axis=-1, keepdims=True)
    var = jnp.mean(jnp.square(xf - mu), axis=-1, keepdims=True)
    y = (xf - mu) * lax.rsqrt(var + LN_EPS)
    if g is not None:
        y = y * g.astype(jnp.float32) + b.astype(jnp.float32)
    return y.astype(x.dtype)


def _rmsnorm(x, g):
    xf = x.astype(jnp.float32)
    y = xf * lax.rsqrt(jnp.mean(jnp.square(xf), axis=-1, keepdims=True) + RMS_EPS)
    return (y * g.astype(jnp.float32)).astype(x.dtype)


def _rope_angles(pos):
    inv = ROPE_THETA ** (-jnp.arange(0, QK_ROPE, 2, dtype=jnp.float32) / QK_ROPE)
    ang = pos.astype(jnp.float32)[:, None] * inv[None, :]
    return jnp.cos(ang), jnp.sin(ang)


def _apply_rope(x, cos, sin):
    half = QK_ROPE // 2
    x1, x2 = x[..., :half], x[..., half:]
    cos = cos.astype(x.dtype)
    sin = sin.astype(x.dtype)
    return jnp.concatenate([x1 * cos - x2 * sin, x1 * sin + x2 * cos], axis=-1)


def _spatial_gating(u, v, ln_g, ln_b, w_s, b_s):
    bsz, t, _ = u.shape
    u = jax.nn.gelu(u)
    v = _layernorm(jax.nn.gelu(v), ln_g, ln_b)
    L = min(t, MLP_CHUNK)
    n = t // L
    idx = jnp.arange(L)
    mask = (idx[None, :] // CHUNK) <= (idx[:, None] // CHUNK)
    ws = w_s[:, :L, :L]
    ws = jnp.where(mask[None], ws, jnp.zeros_like(ws))
    vh = v.reshape(bsz, n, L, N_HEADS_A, HEAD_A)
    s = jnp.einsum('hij,bnjhd->bnihd', ws, vh) + b_s[:, :L].T[None, None, :, :, None]
    return u * s.reshape(bsz, t, W_A), v


def _conv_module(a, past, dw_k, dw_b, ln_g, ln_b, w_pw, b_pw):
    g = a[..., :W_B] * jax.nn.sigmoid(a[..., W_B:])
    xp = jnp.concatenate([past, g], axis=1)
    y = lax.conv_general_dilated(xp, dw_k[:, None, :], (1,), 'VALID',
                                 dimension_numbers=('NWC', 'WIO', 'NWC'),
                                 feature_group_count=W_B) + dw_b
    y = jax.nn.silu(_layernorm(y, ln_g, ln_b))
    y = y @ w_pw + b_pw
    return y, xp[:, -(CONV_W - 1):]


def _attend(q_n, q_r, k_n, k_r, v, q_pos, k_pos):
    s = jnp.einsum('bqhd,bkhd->bhqk', q_n, k_n) + jnp.einsum('bqhr,bkr->bhqk', q_r, k_r)
    s = s.astype(jnp.float32) * ATTN_SCALE
    mask = (k_pos[None, :] // CHUNK) <= (q_pos[:, None] // CHUNK)
    s = jnp.where(mask[None, None], s, -jnp.inf)
    p = jax.nn.softmax(s, axis=-1).astype(v.dtype)
    return jnp.einsum('bhqk,bkhd->bqhd', p, v)


def _layer(x, c, pos0, conv_past, lat_past, kr_past, lp):
    bsz, t, _ = x.shape
    mod = jax.nn.silu(c) @ lp['w_ada'] + lp['b_ada']
    shift, scale, gate = jnp.split(mod[:, None, :], 3, axis=-1)
    h = _layernorm(x) * (1 + scale) + shift
    z = h @ lp['w_in']
    u_a, v_a, g_a, glu_b, g_b, c_q, c_kv, k_r, g_c = jnp.split(z, SPLIT_POINTS, axis=-1)

    y_a, v_state = _spatial_gating(u_a, v_a, lp['gmlp_ln_g'], lp['gmlp_ln_b'], lp['gmlp_ws'], lp['gmlp_bs'])
    y_a = y_a * jax.nn.silu(g_a)

    if conv_past is None:
        conv_past = jnp.zeros((bsz, CONV_W - 1, W_B), x.dtype)
    y_b, conv_state = _conv_module(glu_b, conv_past, lp['conv_dw_k'], lp['conv_dw_b'], lp['conv_ln_g'],
                                   lp['conv_ln_b'], lp['conv_w_pw'], lp['conv_b_pw'])
    y_b = y_b * jax.nn.silu(g_b)

    pos = pos0 + jnp.arange(t, dtype=jnp.int32)
    cos, sin = _rope_angles(pos)
    q = (_rmsnorm(c_q, lp['mla_q_norm']) @ lp['mla_w_uq']).reshape(bsz, t, N_HEADS_C, QK_NOPE + QK_ROPE)
    q_n = q[..., :QK_NOPE]
    q_r = _apply_rope(q[..., QK_NOPE:], cos[:, None, :], sin[:, None, :])
    lat = _rmsnorm(c_kv, lp['mla_kv_norm'])
    k_r = _apply_rope(k_r, cos, sin)
    if lat_past is None:
        lat_all, kr_all, k_pos = lat, k_r, pos
    else:
        lat_all = jnp.concatenate([lat_past, lat], axis=1)
        kr_all = jnp.concatenate([kr_past, k_r], axis=1)
        k_pos = jnp.arange(lat_all.shape[1], dtype=jnp.int32)
    kv = (lat_all @ lp['mla_w_ukv']).reshape(bsz, -1, N_HEADS_C, QK_NOPE + V_DIM)
    k_n, v = kv[..., :QK_NOPE], kv[..., QK_NOPE:]
    if t % Q_BLOCK == 0:
        nblk = t // Q_BLOCK
        qn_b = q_n.reshape(bsz, nblk, Q_BLOCK, N_HEADS_C, QK_NOPE).swapaxes(0, 1)
        qr_b = q_r.reshape(bsz, nblk, Q_BLOCK, N_HEADS_C, QK_ROPE).swapaxes(0, 1)
        pos_b = pos.reshape(nblk, Q_BLOCK)
        o = lax.map(lambda a: _attend(a[0], a[1], k_n, kr_all, v, a[2], k_pos), (qn_b, qr_b, pos_b))
        o = o.swapaxes(0, 1).reshape(bsz, t, W_C)
    else:
        o = _attend(q_n, q_r, k_n, kr_all, v, pos, k_pos).reshape(bsz, t, W_C)
    y_c = o * jax.nn.silu(g_c)

    y = jnp.concatenate([y_a, y_b, y_c], axis=-1) @ lp['w_out']
    x = _layernorm(ALPHA * x + gate * y, lp['post_ln_g'], lp['post_ln_b'])
    return x, v_state, conv_state, lat, k_r


def setup_inputs(seed: int = 0) -> dict:
    key = jax.random.key(seed)
    ks = jax.random.split(key, 32)
    f32 = jnp.float32

    def nrm(k, shape, s):
        return jax.random.normal(k, shape, f32) * s

    return {
        'x_prompt': nrm(ks[0], (BATCH, SEQ, D_MODEL), 1.0),
        'x_sample': nrm(ks[1], (DEC_BATCH, DEC_SEQ, D_MODEL), 1.0),
        'cache_latent': nrm(ks[2], (DEPTH, DEC_BATCH, PAST_LEN, KV_LORA), 1.0),
        'cache_krope': nrm(ks[3], (DEPTH, DEC_BATCH, PAST_LEN, QK_ROPE), 1.0),
        'state_conv': nrm(ks[4], (DEPTH, DEC_BATCH, CONV_W - 1, W_B), 0.5),
        'c_prompt': nrm(ks[5], (BATCH, D_MODEL), 1.0),
        'c_sample': nrm(ks[6], (DEC_BATCH, D_MODEL), 1.0),
        'w_ada': nrm(ks[7], (DEPTH, D_MODEL, 3 * D_MODEL), 0.5 * D_MODEL ** -0.5),
        'b_ada': nrm(ks[8], (DEPTH, 3 * D_MODEL), 0.02),
        'w_in': nrm(ks[9], (DEPTH, D_MODEL, D_IN), D_MODEL ** -0.5),
        'gmlp_ln_g': 1.0 + nrm(ks[10], (DEPTH, W_A), 0.02),
        'gmlp_ln_b': nrm(ks[11], (DEPTH, W_A), 0.02),
        'gmlp_ws': nrm(ks[12], (DEPTH, N_HEADS_A, MLP_CHUNK, MLP_CHUNK), MLP_CHUNK ** -0.5),
        'gmlp_bs': 1.0 + nrm(ks[13], (DEPTH, N_HEADS_A, MLP_CHUNK), 0.01),
        'conv_dw_k': nrm(ks[14], (DEPTH, CONV_W, W_B), CONV_W ** -0.5),
        'conv_dw_b': nrm(ks[15], (DEPTH, W_B), 0.02),
        'conv_ln_g': 1.0 + nrm(ks[16], (DEPTH, W_B), 0.02),
        'conv_ln_b': nrm(ks[17], (DEPTH, W_B), 0.02),
        'conv_w_pw': nrm(ks[18], (DEPTH, W_B, W_B), W_B ** -0.5),
        'conv_b_pw': nrm(ks[19], (DEPTH, W_B), 0.02),
        'mla_q_norm': 1.0 + nrm(ks[20], (DEPTH, Q_LORA), 0.02),
        'mla_w_uq': nrm(ks[21], (DEPTH, Q_LORA, N_HEADS_C * (QK_NOPE + QK_ROPE)), Q_LORA ** -0.5),
        'mla_kv_norm': 1.0 + nrm(ks[22], (DEPTH, KV_LORA), 0.02),
        'mla_w_ukv': nrm(ks[23], (DEPTH, KV_LORA, N_HEADS_C * (QK_NOPE + V_DIM)), KV_LORA ** -0.5),
        'w_out': nrm(ks[24], (DEPTH, D_MIX, D_MODEL), BETA * D_MIX ** -0.5),
        'post_ln_g': 1.0 + nrm(ks[25], (DEPTH, D_MODEL), 0.02),
        'post_ln_b': nrm(ks[26], (DEPTH, D_MODEL), 0.02),
    }


def reference(x_prompt, x_sample, cache_latent, cache_krope, state_conv, c_prompt, c_sample,
              w_ada, b_ada, w_in, gmlp_ln_g, gmlp_ln_b, gmlp_ws, gmlp_bs,
              conv_dw_k, conv_dw_b, conv_ln_g, conv_ln_b, conv_w_pw, conv_b_pw,
              mla_q_norm, mla_w_uq, mla_kv_norm, mla_w_ukv, w_out, post_ln_g, post_ln_b):
    past_len = cache_latent.shape[2]
    xp, xs = x_prompt, x_sample
    p_conv, p_lat, p_kr = [], [], []
    s_conv, s_lat, s_kr, s_v = [], [], [], []
    for l in range(DEPTH):
        lp = dict(w_ada=w_ada[l], b_ada=b_ada[l], w_in=w_in[l],
                  gmlp_ln_g=gmlp_ln_g[l], gmlp_ln_b=gmlp_ln_b[l], gmlp_ws=gmlp_ws[l], gmlp_bs=gmlp_bs[l],
                  conv_dw_k=conv_dw_k[l], conv_dw_b=conv_dw_b[l], conv_ln_g=conv_ln_g[l],
                  conv_ln_b=conv_ln_b[l], conv_w_pw=conv_w_pw[l], conv_b_pw=conv_b_pw[l],
                  mla_q_norm=mla_q_norm[l], mla_w_uq=mla_w_uq[l], mla_kv_norm=mla_kv_norm[l],
                  mla_w_ukv=mla_w_ukv[l], w_out=w_out[l], post_ln_g=post_ln_g[l], post_ln_b=post_ln_b[l])
        xp, _, cp, lp_lat, lp_kr = _layer(xp, c_prompt, 0, None, None, None, lp)
        p_conv.append(cp); p_lat.append(lp_lat); p_kr.append(lp_kr)
        xs, vs, cs, ls_lat, ls_kr = _layer(xs, c_sample, past_len, state_conv[l], cache_latent[l],
                                           cache_krope[l], lp)
        s_conv.append(cs); s_lat.append(ls_lat); s_kr.append(ls_kr); s_v.append(vs)
    return (xp, xs,
            jnp.stack(p_conv), jnp.stack(p_lat), jnp.stack(p_kr),
            jnp.stack(s_conv), jnp.stack(s_lat), jnp.stack(s_kr), jnp.stack(s_v))
```

```cpp
#include <hip/hip_runtime.h>
#include <hip/hip_cooperative_groups.h>
#include <cstdio>
#include <cstdint>
namespace cg = cooperative_groups;

#define DI __device__ __forceinline__
typedef unsigned short bf16_t;
typedef short bf16x8 __attribute__((ext_vector_type(8)));
typedef float f32x16 __attribute__((ext_vector_type(16)));
typedef float f32x4 __attribute__((ext_vector_type(4)));
typedef float f32x2 __attribute__((ext_vector_type(2)));
typedef __bf16 bf16x2_t __attribute__((ext_vector_type(2)));
typedef unsigned u32x4 __attribute__((ext_vector_type(4)));
typedef unsigned u32x2 __attribute__((ext_vector_type(2)));

constexpr int TP = 32768, TS = 128, T = TP + TS, SEQ = 16384, DM = 1024;
constexpr int PAST = 2048, SKV = PAST + 16;
constexpr int SROWS = 8 * SKV;
constexpr int ZLD = 2816;
constexpr int ZC_U = 0, ZC_V = 256, ZC_GA = 512, ZC_GLU = 768, ZC_GB = 1280, ZC_CQ = 1536, ZC_CKV = 1920, ZC_GC = 2176, ZC_KR = 2688;
constexpr float LN_EPS = 1e-5f, RMS_EPS = 1e-6f;
constexpr float ALPHA = 1.41421356237309515f;
constexpr float QSCALE = 0.10206207261596577f * 1.4426950408889634f;

constexpr size_t O_YP = 0, O_YS = 33554432, O_PCONV = 33685504, O_PLAT = 33716224, O_PKR = 50493440,
                 O_SCONV = 52590592, O_SLAT = 52713472, O_SKR = 52779008, O_SV = 52787200;

constexpr size_t al256(size_t x) { return (x + 255) & ~(size_t)255; }
constexpr size_t OFF_WIN = 0;
constexpr size_t OFF_WUQ = OFF_WIN + al256((size_t)2 * 2816 * 1024 * 2);
constexpr size_t OFF_WUKV = OFF_WUQ + al256((size_t)2 * 768 * 384 * 2);
constexpr size_t OFF_WOUT = OFF_WUKV + al256((size_t)2 * 1024 * 256 * 2);
constexpr size_t OFF_WPW = OFF_WOUT + al256((size_t)2 * 1024 * 1024 * 2);
constexpr size_t OFF_WSB = OFF_WPW + al256((size_t)2 * 256 * 256 * 2);
constexpr size_t OFF_MOD = OFF_WSB + al256((size_t)2 * 4 * 128 * 128 * 2);
constexpr size_t OFF_CS = OFF_MOD + al256((size_t)2 * 10 * 3072 * 4);
constexpr size_t OFF_Z = OFF_CS + al256((size_t)16384 * 16 * 8);
constexpr size_t OFF_H = OFF_Z + al256((size_t)T * ZLD * 2);
constexpr size_t OFF_YMIX = OFF_H + al256((size_t)T * 1024 * 2);
constexpr size_t OFF_KP = OFF_YMIX + al256((size_t)T * 1024 * 2);
constexpr size_t OFF_VTP = OFF_KP + al256((size_t)TP * 512 * 2);
constexpr size_t OFF_LATS = OFF_VTP + al256((size_t)TP * 512 * 2);
constexpr size_t OFF_KRS = OFF_LATS + al256((size_t)2 * SROWS * 256 * 2);
constexpr size_t OFF_KVS = OFF_KRS + al256((size_t)2 * SROWS * 32 * 2);
constexpr size_t OFF_SSCR = OFF_KVS + al256((size_t)SROWS * 1024 * 2);
constexpr size_t WS_NEED = OFF_SSCR + al256((size_t)64 * SKV * 16 * 4);

struct Params {
  const float *x_prompt, *x_sample, *cache_latent, *cache_krope, *state_conv, *c_prompt, *c_sample;
  const float *w_ada, *b_ada, *w_in, *gmlp_ln_g, *gmlp_ln_b, *gmlp_ws, *gmlp_bs, *conv_dw_k, *conv_dw_b, *conv_ln_g, *conv_ln_b,
      *conv_w_pw, *conv_b_pw, *mla_q_norm, *mla_w_uq, *mla_kv_norm, *mla_w_ukv, *w_out, *post_ln_g, *post_ln_b;
  float* out;
  char* ws;
};

DI unsigned pk2(float a, float b) { f32x2 v = {a, b}; return __builtin_bit_cast(unsigned, __builtin_convertvector(v, bf16x2_t)); }
DI bf16_t f2bf(float a) { return (bf16_t)(pk2(a, 0.f) & 0xffffu); }
DI float bflo(unsigned u) { return __uint_as_float(u << 16); }
DI float bfhi(unsigned u) { return __uint_as_float(u & 0xffff0000u); }
DI float bf2f(bf16_t v) { return __uint_as_float((unsigned)v << 16); }
DI float sigmoidf_(float x) { return 1.0f / (1.0f + __expf(-x)); }
DI float siluf_(float x) { return x / (1.0f + __expf(-x)); }
DI float geluf_(float x) { const float y = 0.7978845608028654f * (x + 0.044715f * x * x * x); return x / (1.0f + __expf(-2.0f * y)); }
DI float wsum(float v) {
#pragma unroll
  for (int o = 32; o > 0; o >>= 1) v += __shfl_xor(v, o);
  return v;
}
DI f32x16 mfma32(bf16x8 a, bf16x8 b, f32x16 c) { return __builtin_amdgcn_mfma_f32_32x32x16_bf16(a, b, c, 0, 0, 0); }
DI f32x16 zero16() { f32x16 z; for (int i = 0; i < 16; ++i) z[i] = 0.f; return z; }
DI int swap23(int x) { return (x & ~12) | ((x & 4) << 1) | ((x & 8) >> 1); }
DI int mod_row(int t) { return t < TP ? (t >> 14) : 2 + ((t - TP) >> 4); }
DI int tok_pos(int t) { return t < TP ? (t & (SEQ - 1)) : PAST + ((t - TP) & 15); }

constexpr int GROW = 144;
constexpr int GTILE = 128 * GROW;
constexpr int GSTAGE = 2 * GTILE;
constexpr int LDS_BYTES = 2 * GSTAGE;

template <class Epi>
DI void gemm_tile(const bf16_t* __restrict__ A, int lda, const bf16_t* __restrict__ Bt, int ldb, int K, int m0, int n0, char* lds, const Epi& epi) {
  const int tid = threadIdx.x, lane = tid & 63, w = tid >> 6, wm = w >> 1, wn = w & 1;
  const int lrow = tid >> 3, lkc = tid & 7;
  const bf16_t* ag = A + (size_t)(m0 + lrow) * lda + lkc * 8;
  const bf16_t* bg = Bt + (size_t)(n0 + lrow) * ldb + lkc * 8;
  u32x4 ra[4], rb[4];
#pragma unroll
  for (int i = 0; i < 4; ++i) { ra[i] = *(const u32x4*)(ag + (size_t)(32 * i) * lda); rb[i] = *(const u32x4*)(bg + (size_t)(32 * i) * ldb); }
  char* lw = lds + lrow * GROW + lkc * 16;
#pragma unroll
  for (int i = 0; i < 4; ++i) { *(u32x4*)(lw + 32 * i * GROW) = ra[i]; *(u32x4*)(lw + GTILE + 32 * i * GROW) = rb[i]; }
  __syncthreads();
  f32x16 acc[2][2];
#pragma unroll
  for (int i = 0; i < 2; ++i)
#pragma unroll
    for (int j = 0; j < 2; ++j) acc[i][j] = zero16();
  const int nk = K >> 6;
  const int fro = (lane & 31) * GROW + (lane >> 5) * 16;
  for (int kt = 0; kt < nk; ++kt) {
    if (kt + 1 < nk) {
#pragma unroll
      for (int i = 0; i < 4; ++i) { ra[i] = *(const u32x4*)(ag + (size_t)(32 * i) * lda + (kt + 1) * 64); rb[i] = *(const u32x4*)(bg + (size_t)(32 * i) * ldb + (kt + 1) * 64); }
    }
    const char* sa = lds + (kt & 1) * GSTAGE + wm * 64 * GROW + fro;
    const char* sb = lds + (kt & 1) * GSTAGE + GTILE + wn * 64 * GROW + fro;
#pragma unroll
    for (int s = 0; s < 4; ++s) {
      const bf16x8 a0 = *(const bf16x8*)(sa + s * 32), a1 = *(const bf16x8*)(sa + 32 * GROW + s * 32);
      const bf16x8 b0 = *(const bf16x8*)(sb + s * 32), b1 = *(const bf16x8*)(sb + 32 * GROW + s * 32);
      acc[0][0] = mfma32(b0, a0, acc[0][0]);
      acc[0][1] = mfma32(b1, a0, acc[0][1]);
      acc[1][0] = mfma32(b0, a1, acc[1][0]);
      acc[1][1] = mfma32(b1, a1, acc[1][1]);
    }
    if (kt + 1 < nk) {
      char* lw2 = lw + ((kt + 1) & 1) * GSTAGE;
#pragma unroll
      for (int i = 0; i < 4; ++i) { *(u32x4*)(lw2 + 32 * i * GROW) = ra[i]; *(u32x4*)(lw2 + GTILE + 32 * i * GROW) = rb[i]; }
    }
    __syncthreads();
  }
#pragma unroll
  for (int i = 0; i < 2; ++i)
#pragma unroll
    for (int j = 0; j < 2; ++j) epi(m0 + wm * 64 + i * 32 + (lane & 31), n0 + wn * 64 + j * 32, lane >> 5, acc[i][j]);
}

DI void transpose_unit(const float* __restrict__ src, int lds_src, bf16_t* __restrict__ dst, int K, int k0, int n0, int kind, char* lds) {
  float* tile = (float*)lds;
  const int tid = threadIdx.x;
  const int nn = tid & 63, kq = tid >> 6;
  const int np = n0 + nn;
  int sc;
  if (kind == 0) { sc = np < 2176 ? np : (np < 2688 ? np + 32 : (np < 2720 ? np - 512 : -1)); }
  else if (kind == 2) { sc = np < 512 ? ((np >> 6) * 128 + (np & 63)) : (((np - 512) >> 6) * 128 + 64 + (np & 63)); }
  else sc = np;
#pragma unroll 4
  for (int i = 0; i < 16; ++i) {
    const int kk = kq * 16 + i;
    tile[kk * 65 + nn] = sc >= 0 ? src[(size_t)(k0 + kk) * lds_src + sc] : 0.f;
  }
  __syncthreads();
  const int kk = tid & 63, nq = tid >> 6;
#pragma unroll 4
  for (int i = 0; i < 16; ++i) {
    const int n2 = nq * 16 + i;
    dst[(size_t)(n0 + n2) * K + k0 + kk] = f2bf(tile[kk * 65 + n2]);
  }
  __syncthreads();
}

DI void mod_unit(const Params& p, int l, int cg0, char* lds) {
  float* sc = (float*)lds;
  float* red = sc + 10 * 1024;
  const int tid = threadIdx.x;
  for (int e = tid; e < 10 * 1024; e += 256) {
    const int r = e >> 10, k = e & 1023;
    const float c = r < 2 ? p.c_prompt[r * 1024 + k] : p.c_sample[(r - 2) * 1024 + k];
    sc[e] = siluf_(c);
  }
  __syncthreads();
  const int col = cg0 * 32 + (tid & 31), kg = tid >> 5;
  float acc[10];
#pragma unroll
  for (int r = 0; r < 10; ++r) acc[r] = 0.f;
  const float* wp = p.w_ada + (size_t)l * 1024 * 3072 + col;
  for (int k = kg * 128; k < kg * 128 + 128; ++k) {
    const float wv = wp[(size_t)k * 3072];
#pragma unroll
    for (int r = 0; r < 10; ++r) acc[r] += sc[r * 1024 + k] * wv;
  }
#pragma unroll
  for (int r = 0; r < 10; ++r) red[(kg * 10 + r) * 32 + (tid & 31)] = acc[r];
  __syncthreads();
  float* mod = (float*)(p.ws + OFF_MOD);
  for (int e = tid; e < 320; e += 256) {
    const int r = e >> 5, c = e & 31;
    float s = 0.f;
#pragma unroll
    for (int g = 0; g < 8; ++g) s += red[(g * 10 + r) * 32 + c];
    mod[((size_t)l * 10 + r) * 3072 + cg0 * 32 + c] = s + p.b_ada[l * 3072 + cg0 * 32 + c];
  }
  __syncthreads();
}

DI void phase_prep(const Params& p, char* lds) {
  constexpr int PER_L = 704 + 72 + 64 + 256 + 16;
  for (int u = blockIdx.x; u < 2 * PER_L + 192; u += gridDim.x) {
    if (u >= 2 * PER_L) { const int v = u - 2 * PER_L; mod_unit(p, v / 96, v % 96, lds); continue; }
    const int l = u / PER_L; int v = u % PER_L;
    if (v < 704) { transpose_unit(p.w_in + (size_t)l * 1024 * 2720, 2720, (bf16_t*)(p.ws + OFF_WIN) + (size_t)l * 2816 * 1024, 1024, (v % 16) * 64, (v / 16) * 64, 0, lds); continue; }
    v -= 704;
    if (v < 72) { transpose_unit(p.mla_w_uq + (size_t)l * 384 * 768, 768, (bf16_t*)(p.ws + OFF_WUQ) + (size_t)l * 768 * 384, 384, (v % 6) * 64, (v / 6) * 64, 1, lds); continue; }
    v -= 72;
    if (v < 64) { transpose_unit(p.mla_w_ukv + (size_t)l * 256 * 1024, 1024, (bf16_t*)(p.ws + OFF_WUKV) + (size_t)l * 1024 * 256, 256, (v % 4) * 64, (v / 4) * 64, 2, lds); continue; }
    v -= 64;
    if (v < 256) { transpose_unit(p.w_out + (size_t)l * 1024 * 1024, 1024, (bf16_t*)(p.ws + OFF_WOUT) + (size_t)l * 1024 * 1024, 1024, (v % 16) * 64, (v / 16) * 64, 1, lds); continue; }
    v -= 256;
    transpose_unit(p.conv_w_pw + (size_t)l * 256 * 256, 256, (bf16_t*)(p.ws + OFF_WPW) + (size_t)l * 256 * 256, 256, (v % 4) * 64, (v / 4) * 64, 1, lds);
  }
  const size_t gt = (size_t)blockIdx.x * 256 + threadIdx.x, gn = (size_t)gridDim.x * 256;
  {
    bf16_t* wsb = (bf16_t*)(p.ws + OFF_WSB);
    for (size_t e = gt; e < (size_t)2 * 4 * 128 * 128; e += gn) {
      const int j = e & 127, i = (e >> 7) & 127;
      wsb[e] = f2bf(((j >> 6) <= (i >> 6)) ? p.gmlp_ws[e] : 0.f);
    }
  }
  {
    bf16_t* lats = (bf16_t*)(p.ws + OFF_LATS);
    for (size_t e = gt; e < (size_t)2 * 8 * PAST * 64; e += gn) {
      const size_t c4 = e & 63, row = (e >> 6) & (PAST - 1), lb = e >> 17;
      const f32x4 v = *(const f32x4*)(p.cache_latent + e * 4);
      u32x2 o; o.x = pk2(v[0], v[1]); o.y = pk2(v[2], v[3]);
      *(u32x2*)(lats + (lb * SKV + row) * 256 + c4 * 4) = o;
    }
    bf16_t* krs = (bf16_t*)(p.ws + OFF_KRS);
    for (size_t e = gt; e < (size_t)2 * 8 * PAST * 8; e += gn) {
      const size_t c4 = e & 7, row = (e >> 3) & (PAST - 1), lb = e >> 14;
      const f32x4 v = *(const f32x4*)(p.cache_krope + e * 4);
      u32x2 o; o.x = pk2(v[0], v[1]); o.y = pk2(v[2], v[3]);
      *(u32x2*)(krs + (lb * SKV + row) * 32 + c4 * 4) = o;
    }
  }
  {
    f32x2* cs = (f32x2*)(p.ws + OFF_CS);
    for (size_t e = gt; e < (size_t)16384 * 16; e += gn) {
      const int i = e & 15, pos = (int)(e >> 4);
      const double invrev = exp2(-(double)i * (13.287712379549449 / 16.0)) * 0.15915494309189535;
      double rev = (double)pos * invrev;
      rev -= rint(rev);
      const float fr = (float)rev;
      f32x2 o; o.x = __builtin_amdgcn_cosf(fr); o.y = __builtin_amdgcn_sinf(fr);
      cs[e] = o;
    }
  }
  {
    for (size_t e = gt; e < (size_t)16 * 14 * 256; e += gn) {
      const size_t c = e & 255, j = (e >> 8) % 14, lb = e / (14 * 256);
      p.out[O_SCONV + (lb * 30 + j) * 256 + c] = p.state_conv[(lb * 30 + 16 + j) * 256 + c];
    }
  }
}

DI void phase_ln(const Params& p, int mode) {
  const int lane = threadIdx.x & 63;
  const int gw = blockIdx.x * 4 + (threadIdx.x >> 6), nw = gridDim.x * 4;
  const float* r = (const float*)(p.ws + OFF_Z);
  bf16_t* hb = (bf16_t*)(p.ws + OFF_H);
  const float* mod = (const float*)(p.ws + OFF_MOD);
  for (int t = gw; t < T; t += nw) {
    const float* src = mode == 0 ? (t < TP ? p.x_prompt + (size_t)t * 1024 : p.x_sample + (size_t)(t - TP) * 1024) : r + (size_t)t * 1024;
    f32x4 v[4];
#pragma unroll
    for (int i = 0; i < 4; ++i) v[i] = *(const f32x4*)(src + lane * 4 + 256 * i);
    float s = 0.f;
#pragma unroll
    for (int i = 0; i < 4; ++i) s += (v[i][0] + v[i][1]) + (v[i][2] + v[i][3]);
    float mu = wsum(s) * (1.0f / 1024.0f);
    float q = 0.f;
#pragma unroll
    for (int i = 0; i < 4; ++i) { const f32x4 d = v[i] - mu; q += (d[0] * d[0] + d[1] * d[1]) + (d[2] * d[2] + d[3] * d[3]); }
    float rstd = rsqrtf(wsum(q) * (1.0f / 1024.0f) + LN_EPS);
    if (mode >= 1) {
      const int pl = mode - 1;
      s = 0.f;
#pragma unroll
      for (int i = 0; i < 4; ++i) {
        const f32x4 g = *(const f32x4*)(p.post_ln_g + pl * 1024 + lane * 4 + 256 * i), b = *(const f32x4*)(p.post_ln_b + pl * 1024 + lane * 4 + 256 * i);
        v[i] = (v[i] - mu) * rstd * g + b;
        *(f32x4*)(p.out + (size_t)t * 1024 + lane * 4 + 256 * i) = v[i];
        s += (v[i][0] + v[i][1]) + (v[i][2] + v[i][3]);
      }
      if (mode == 2) continue;
      mu = wsum(s) * (1.0f / 1024.0f);
      q = 0.f;
#pragma unroll
      for (int i = 0; i < 4; ++i) { const f32x4 d = v[i] - mu; q += (d[0] * d[0] + d[1] * d[1]) + (d[2] * d[2] + d[3] * d[3]); }
      rstd = rsqrtf(wsum(q) * (1.0f / 1024.0f) + LN_EPS);
    }
    const int l = mode == 0 ? 0 : 1;
    const float* mr = mod + ((size_t)l * 10 + mod_row(t)) * 3072;
#pragma unroll
    for (int i = 0; i < 4; ++i) {
      const f32x4 sh = *(const f32x4*)(mr + lane * 4 + 256 * i), sc = *(const f32x4*)(mr + 1024 + lane * 4 + 256 * i);
      const f32x4 o = (v[i] - mu) * rstd * (1.0f + sc) + sh;
      u32x2 w; w.x = pk2(o[0], o[1]); w.y = pk2(o[2], o[3]);
      *(u32x2*)(hb + (size_t)t * 1024 + lane * 4 + 256 * i) = w;
    }
  }
}

struct EpiZ {
  bf16_t* z;
  DI void operator()(int m, int nb, int hh, const f32x16& acc) const {
    const int act = nb < 512 ? 1 : (nb < 768 ? 2 : (nb < 1280 ? 0 : (nb < 1536 ? 2 : (nb < 2176 ? 0 : (nb < 2688 ? 2 : 0)))));
#pragma unroll
    for (int g = 0; g < 4; ++g) {
      float v0 = acc[4 * g], v1 = acc[4 * g + 1], v2 = acc[4 * g + 2], v3 = acc[4 * g + 3];
      if (act == 1) { v0 = geluf_(v0); v1 = geluf_(v1); v2 = geluf_(v2); v3 = geluf_(v3); }
      else if (act == 2) { v0 = siluf_(v0); v1 = siluf_(v1); v2 = siluf_(v2); v3 = siluf_(v3); }
      u32x2 w; w.x = pk2(v0, v1); w.y = pk2(v2, v3);
      *(u32x2*)(z + (size_t)m * ZLD + nb + 8 * g + 4 * hh) = w;
    }
  }
};
DI void phase_zgemm(const Params& p, int l, char* lds) {
  const bf16_t* hb = (const bf16_t*)(p.ws + OFF_H);
  const bf16_t* wt = (const bf16_t*)(p.ws + OFF_WIN) + (size_t)l * 2816 * 1024;
  EpiZ epi{(bf16_t*)(p.ws + OFF_Z)};
  for (int u = blockIdx.x; u < 257 * 22; u += gridDim.x) gemm_tile(hb, 1024, wt, 1024, 1024, (u / 22) * 128, (u % 22) * 128, lds, epi);
}

DI void phase_rows(const Params& p, int l) {
  const int lane = threadIdx.x & 63;
  const int gw = blockIdx.x * 4 + (threadIdx.x >> 6), nw = gridDim.x * 4;
  bf16_t* z = (bf16_t*)(p.ws + OFF_Z);
  const f32x2* cs = (const f32x2*)(p.ws + OFF_CS);
  for (int t = gw; t < T; t += nw) {
    bf16_t* zr = z + (size_t)t * ZLD;
    const bool samp = t >= TP;
    const int sb = (t - TP) >> 4, si = (t - TP) & 15;
    const int pb = t >> 14, pos = tok_pos(t);
    {
      const u32x2 raw = *(const u32x2*)(zr + ZC_V + lane * 4);
      f32x4 v = {bflo(raw.x), bfhi(raw.x), bflo(raw.y), bfhi(raw.y)};
      const float mu = wsum((v[0] + v[1]) + (v[2] + v[3])) * (1.0f / 256.0f);
      const f32x4 d = v - mu;
      const float rstd = rsqrtf(wsum((d[0] * d[0] + d[1] * d[1]) + (d[2] * d[2] + d[3] * d[3])) * (1.0f / 256.0f) + LN_EPS);
      const f32x4 g = *(const f32x4*)(p.gmlp_ln_g + l * 256 + lane * 4), b = *(const f32x4*)(p.gmlp_ln_b + l * 256 + lane * 4);
      v = d * rstd * g + b;
      u32x2 w; w.x = pk2(v[0], v[1]); w.y = pk2(v[2], v[3]);
      *(u32x2*)(zr + ZC_V + lane * 4) = w;
      if (samp) *(f32x4*)(p.out + O_SV + ((size_t)(l * 8 + sb) * 16 + si) * 256 + lane * 4) = v;
    }
    {
      const u32x2 ra = *(const u32x2*)(zr + ZC_GLU + lane * 4), rg = *(const u32x2*)(zr + ZC_GLU + 256 + lane * 4);
      f32x4 g;
      g[0] = bflo(ra.x) * sigmoidf_(bflo(rg.x)); g[1] = bfhi(ra.x) * sigmoidf_(bfhi(rg.x));
      g[2] = bflo(ra.y) * sigmoidf_(bflo(rg.y)); g[3] = bfhi(ra.y) * sigmoidf_(bfhi(rg.y));
      u32x2 w; w.x = pk2(g[0], g[1]); w.y = pk2(g[2], g[3]);
      *(u32x2*)(zr + ZC_GLU + lane * 4) = w;
      if (samp) *(f32x4*)(p.out + O_SCONV + ((size_t)(l * 8 + sb) * 30 + 14 + si) * 256 + lane * 4) = g;
      else if (pos >= SEQ - 30) *(f32x4*)(p.out + O_PCONV + ((size_t)(l * 2 + pb) * 30 + (pos - (SEQ - 30))) * 256 + lane * 4) = g;
    }
    {
      const unsigned* cp = (const unsigned*)(zr + ZC_CQ + lane * 6);
      const unsigned r0 = cp[0], r1 = cp[1], r2 = cp[2];
      float v[6] = {bflo(r0), bfhi(r0), bflo(r1), bfhi(r1), bflo(r2), bfhi(r2)};
      float q = 0.f;
#pragma unroll
      for (int i = 0; i < 6; ++i) q += v[i] * v[i];
      const float rr = rsqrtf(wsum(q) * (1.0f / 384.0f) + RMS_EPS);
      const float* gq = p.mla_q_norm + l * 384 + lane * 6;
#pragma unroll
      for (int i = 0; i < 6; ++i) v[i] = v[i] * rr * gq[i];
      unsigned* op = (unsigned*)(zr + ZC_CQ + lane * 6);
      op[0] = pk2(v[0], v[1]); op[1] = pk2(v[2], v[3]); op[2] = pk2(v[4], v[5]);
    }
    {
      const u32x2 raw = *(const u32x2*)(zr + ZC_CKV + lane * 4);
      f32x4 v = {bflo(raw.x), bfhi(raw.x), bflo(raw.y), bfhi(raw.y)};
      const float rr = rsqrtf(wsum((v[0] * v[0] + v[1] * v[1]) + (v[2] * v[2] + v[3] * v[3])) * (1.0f / 256.0f) + RMS_EPS);
      const f32x4 g = *(const f32x4*)(p.mla_kv_norm + l * 256 + lane * 4);
      v = v * rr * g;
      u32x2 w; w.x = pk2(v[0], v[1]); w.y = pk2(v[2], v[3]);
      if (samp) {
        *(f32x4*)(p.out + O_SLAT + ((size_t)(l * 8 + sb) * 16 + si) * 256 + lane * 4) = v;
        *(u32x2*)((bf16_t*)(p.ws + OFF_LATS) + ((size_t)(l * 8 + sb) * SKV + PAST + si) * 256 + lane * 4) = w;
      } else {
        *(f32x4*)(p.out + O_PLAT + ((size_t)(l * 2 + pb) * SEQ + pos) * 256 + lane * 4) = v;
        *(u32x2*)(zr + ZC_CKV + lane * 4) = w;
      }
    }
    if (lane < 16) {
      const float x1 = bf2f(zr[ZC_KR + lane]), x2 = bf2f(zr[ZC_KR + 16 + lane]);
      const f32x2 c = cs[pos * 16 + lane];
      const float o1 = x1 * c.x - x2 * c.y, o2 = x1 * c.y + x2 * c.x;
      if (samp) {
        float* o = p.out + O_SKR + ((size_t)(l * 8 + sb) * 16 + si) * 32;
        o[lane] = o1; o[16 + lane] = o2;
        bf16_t* kb = (bf16_t*)(p.ws + OFF_KRS) + ((size_t)(l * 8 + sb) * SKV + PAST + si) * 32;
        kb[lane] = f2bf(o1); kb[16 + lane] = f2bf(o2);
      } else {
        float* o = p.out + O_PKR + ((size_t)(l * 2 + pb) * SEQ + pos) * 32;
        o[lane] = o1; o[16 + lane] = o2;
        zr[ZC_KR + lane] = f2bf(o1); zr[ZC_KR + 16 + lane] = f2bf(o2);
      }
    }
  }
}

struct EpiQ {
  bf16_t* q; const f32x2* cs;
  DI void operator()(int m, int nb, int hh, const f32x16& acc) const {
    bf16_t* qr = q + (size_t)m * 768 + nb;
    if ((nb % 96) == 64) {
      const int pos = tok_pos(m);
#pragma unroll
      for (int g = 0; g < 2; ++g) {
        const int i0 = 8 * g + 4 * hh;
        float o1[4], o2[4];
#pragma unroll
        for (int c = 0; c < 4; ++c) {
          const f32x2 t = cs[pos * 16 + i0 + c];
          const float x1 = acc[4 * g + c] * QSCALE, x2 = acc[4 * (g + 2) + c] * QSCALE;
          o1[c] = x1 * t.x - x2 * t.y; o2[c] = x1 * t.y + x2 * t.x;
        }
        u32x2 w1, w2; w1.x = pk2(o1[0], o1[1]); w1.y = pk2(o1[2], o1[3]); w2.x = pk2(o2[0], o2[1]); w2.y = pk2(o2[2], o2[3]);
        *(u32x2*)(qr + i0) = w1; *(u32x2*)(qr + 16 + i0) = w2;
      }
    } else {
#pragma unroll
      for (int g = 0; g < 4; ++g) {
        u32x2 w; w.x = pk2(acc[4 * g] * QSCALE, acc[4 * g + 1] * QSCALE); w.y = pk2(acc[4 * g + 2] * QSCALE, acc[4 * g + 3] * QSCALE);
        *(u32x2*)(qr + 8 * g + 4 * hh) = w;
      }
    }
  }
};
struct EpiStore {
  bf16_t* c; int ldc;
  DI void operator()(int m, int nb, int hh, const f32x16& acc) const {
#pragma unroll
    for (int g = 0; g < 4; ++g) {
      u32x2 w; w.x = pk2(acc[4 * g], acc[4 * g + 1]); w.y = pk2(acc[4 * g + 2], acc[4 * g + 3]);
      *(u32x2*)(c + (size_t)m * ldc + nb + 8 * g + 4 * hh) = w;
    }
  }
};
struct EpiVt {
  bf16_t* vt;
  DI void operator()(int m, int nb, int hh, const f32x16& acc) const {
#pragma unroll
    for (int g = 0; g < 4; ++g) {
      const int tok = nb + 8 * g + 4 * hh, b = tok >> 14, pos = swap23(tok & (SEQ - 1));
      u32x2 w; w.x = pk2(acc[4 * g], acc[4 * g + 1]); w.y = pk2(acc[4 * g + 2], acc[4 * g + 3]);
      *(u32x2*)(vt + ((size_t)(b * 512 + m)) * SEQ + pos) = w;
    }
  }
};

DI void gate_unit(const Params& p, int l, int ck, int hd, char* lds) {
  const int tid = threadIdx.x, lane = tid & 63, w = tid >> 6;
  const bf16_t* z = (const bf16_t*)(p.ws + OFF_Z);
  const int t0 = ck * 128;
  constexpr int VROW = 272;
#pragma unroll
  for (int i = 0; i < 4; ++i) {
    const int c = tid + 256 * i, j = c >> 3, d0 = (c & 7) * 8;
    const u32x4 raw = *(const u32x4*)(z + (size_t)(t0 + j) * ZLD + ZC_V + hd * 64 + d0);
    bf16_t* dst = (bf16_t*)(lds + d0 * VROW) + j;
    dst[0 * (VROW / 2)] = (bf16_t)(raw.x & 0xffff); dst[1 * (VROW / 2)] = (bf16_t)(raw.x >> 16);
    dst[2 * (VROW / 2)] = (bf16_t)(raw.y & 0xffff); dst[3 * (VROW / 2)] = (bf16_t)(raw.y >> 16);
    dst[4 * (VROW / 2)] = (bf16_t)(raw.z & 0xffff); dst[5 * (VROW / 2)] = (bf16_t)(raw.z >> 16);
    dst[6 * (VROW / 2)] = (bf16_t)(raw.w & 0xffff); dst[7 * (VROW / 2)] = (bf16_t)(raw.w >> 16);
  }
  __syncthreads();
  const bf16_t* wsb = (const bf16_t*)(p.ws + OFF_WSB) + ((size_t)(l * 4 + hd) * 128 + w * 32 + (lane & 31)) * 128 + (lane >> 5) * 8;
  f32x16 a0 = zero16(), a1 = zero16();
  const int ns = w < 2 ? 4 : 8;
  const char* vb = lds + (lane & 31) * VROW + (lane >> 5) * 16;
  for (int s = 0; s < ns; ++s) {
    const bf16x8 af = *(const bf16x8*)(wsb + s * 16);
    const bf16x8 b0 = *(const bf16x8*)(vb + s * 32), b1 = *(const bf16x8*)(vb + 32 * VROW + s * 32);
    a0 = mfma32(b0, af, a0); a1 = mfma32(b1, af, a1);
  }
  const int i = w * 32 + (lane & 31), t = t0 + i, hh = lane >> 5;
  const float bs = p.gmlp_bs[(l * 4 + hd) * 128 + i];
  const bf16_t* zr = z + (size_t)t * ZLD;
  bf16_t* ym = (bf16_t*)(p.ws + OFF_YMIX) + (size_t)t * 1024;
#pragma unroll
  for (int jb = 0; jb < 2; ++jb)
#pragma unroll
    for (int g = 0; g < 4; ++g) {
      const int d = hd * 64 + jb * 32 + 8 * g + 4 * hh;
      const u32x2 u = *(const u32x2*)(zr + ZC_U + d), ga = *(const u32x2*)(zr + ZC_GA + d);
      const f32x16& a = jb ? a1 : a0;
      u32x2 o;
      o.x = pk2(bflo(u.x) * (a[4 * g] + bs) * bflo(ga.x), bfhi(u.x) * (a[4 * g + 1] + bs) * bfhi(ga.x));
      o.y = pk2(bflo(u.y) * (a[4 * g + 2] + bs) * bflo(ga.y), bfhi(u.y) * (a[4 * g + 3] + bs) * bfhi(ga.y));
      *(u32x2*)(ym + d) = o;
    }
  __syncthreads();
}

DI void sgate_unit(const Params& p, int l, int b) {
  const int c = threadIdx.x, hd = c >> 6;
  const bf16_t* z = (const bf16_t*)(p.ws + OFF_Z) + (size_t)(TP + b * 16) * ZLD;
  float v[16];
#pragma unroll
  for (int j = 0; j < 16; ++j) v[j] = bf2f(z[(size_t)j * ZLD + ZC_V + c]);
  const float* ws = p.gmlp_ws + (size_t)(l * 4 + hd) * 128 * 128;
  bf16_t* ym = (bf16_t*)(p.ws + OFF_YMIX) + (size_t)(TP + b * 16) * 1024;
#pragma unroll 1
  for (int i = 0; i < 16; ++i) {
    float s = p.gmlp_bs[(l * 4 + hd) * 128 + i];
#pragma unroll
    for (int j = 0; j < 16; ++j) s += ws[i * 128 + j] * v[j];
    const float u = bf2f(z[(size_t)i * ZLD + ZC_U + c]), ga = bf2f(z[(size_t)i * ZLD + ZC_GA + c]);
    ym[(size_t)i * 1024 + c] = f2bf(u * s * ga);
  }
}

DI void conv_unit(const Params& p, int l, int cu, char* lds) {
  const int tid = threadIdx.x, lane = tid & 63, w = tid >> 6;
  const bf16_t* z = (const bf16_t*)(p.ws + OFF_Z);
  const bool samp = cu >= 1024;
  const int ntok = samp ? 16 : 32;
  const int t0 = samp ? TP + (cu - 1024) * 16 : cu * 32;
  const int pos0 = samp ? 0 : (t0 & (SEQ - 1));
  char* gt = lds;
  float* yb = (float*)(lds + 32768);
  const int nrows = ntok + 30;
  for (int c = tid; c < nrows * 32; c += 256) {
    const int j = c >> 5, ch = (c & 31) * 8;
    u32x4 v = {0u, 0u, 0u, 0u};
    if (samp) {
      if (j < 30) {
        const float* s = p.state_conv + ((size_t)(l * 8 + (cu - 1024)) * 30 + j) * 256 + ch;
        const f32x4 a = *(const f32x4*)s, b = *(const f32x4*)(s + 4);
        v.x = pk2(a[0], a[1]); v.y = pk2(a[2], a[3]); v.z = pk2(b[0], b[1]); v.w = pk2(b[2], b[3]);
      } else v = *(const u32x4*)(z + (size_t)(t0 + j - 30) * ZLD + ZC_GLU + ch);
    } else {
      if (pos0 + j - 30 >= 0) v = *(const u32x4*)(z + (size_t)(t0 + j - 30) * ZLD + ZC_GLU + ch);
    }
    *(u32x4*)(gt + j * 512 + ch * 2) = v;
  }
  __syncthreads();
  {
    const int cp = tid & 127, half = tid >> 7;
    float w0[31], w1[31];
#pragma unroll
    for (int k = 0; k < 31; ++k) { const f32x2 wv = *(const f32x2*)(p.conv_dw_k + ((size_t)l * 31 + k) * 256 + cp * 2); w0[k] = wv.x; w1[k] = wv.y; }
    const f32x2 bv = *(const f32x2*)(p.conv_dw_b + l * 256 + cp * 2);
    const int nt2 = ntok >> 1;
    for (int tt = half * nt2; tt < half * nt2 + nt2; ++tt) {
      float a0 = bv.x, a1 = bv.y;
#pragma unroll
      for (int k = 0; k < 31; ++k) {
        const unsigned u = *(const unsigned*)(gt + (tt + k) * 512 + cp * 4);
        a0 += bflo(u) * w0[k]; a1 += bfhi(u) * w1[k];
      }
      *(f32x2*)(yb + tt * 256 + cp * 2) = (f32x2){a0, a1};
    }
  }
  __syncthreads();
  constexpr int AROW = 528;
  {
    const f32x4 g = *(const f32x4*)(p.conv_ln_g + l * 256 + lane * 4), b = *(const f32x4*)(p.conv_ln_b + l * 256 + lane * 4);
    for (int tt = w; tt < 32; tt += 4) {
      u32x2 o = {0u, 0u};
      if (tt < ntok) {
        const f32x4 v = *(const f32x4*)(yb + tt * 256 + lane * 4);
        const float mu = wsum((v[0] + v[1]) + (v[2] + v[3])) * (1.0f / 256.0f);
        const f32x4 d = v - mu;
        const float rstd = rsqrtf(wsum((d[0] * d[0] + d[1] * d[1]) + (d[2] * d[2] + d[3] * d[3])) * (1.0f / 256.0f) + LN_EPS);
        const f32x4 y = d * rstd * g + b;
        o.x = pk2(siluf_(y[0]), siluf_(y[1])); o.y = pk2(siluf_(y[2]), siluf_(y[3]));
      }
      *(u32x2*)(gt + tt * AROW + lane * 8) = o;
    }
  }
  __syncthreads();
  {
    const bf16_t* wp = (const bf16_t*)(p.ws + OFF_WPW) + (size_t)l * 256 * 256 + (size_t)(w * 64 + (lane & 31)) * 256 + (lane >> 5) * 8;
    const char* ab = gt + (lane & 31) * AROW + (lane >> 5) * 16;
    f32x16 a0 = zero16(), a1 = zero16();
#pragma unroll 4
    for (int s = 0; s < 16; ++s) {
      const bf16x8 af = *(const bf16x8*)(ab + s * 32);
      const bf16x8 b0 = *(const bf16x8*)(wp + s * 16), b1 = *(const bf16x8*)(wp + 32 * 256 + s * 16);
      a0 = mfma32(b0, af, a0); a1 = mfma32(b1, af, a1);
    }
    const int i = lane & 31, hh = lane >> 5;
    if (i < ntok) {
      const int t = t0 + i;
      const bf16_t* zr = z + (size_t)t * ZLD + ZC_GB;
      bf16_t* ym = (bf16_t*)(p.ws + OFF_YMIX) + (size_t)t * 1024 + 256;
#pragma unroll
      for (int jb = 0; jb < 2; ++jb)
#pragma unroll
        for (int g = 0; g < 4; ++g) {
          const int n = w * 64 + jb * 32 + 8 * g + 4 * hh;
          const f32x4 bp = *(const f32x4*)(p.conv_b_pw + l * 256 + n);
          const u32x2 gb = *(const u32x2*)(zr + n);
          const f32x16& a = jb ? a1 : a0;
          u32x2 o;
          o.x = pk2((a[4 * g] + bp[0]) * bflo(gb.x), (a[4 * g + 1] + bp[1]) * bfhi(gb.x));
          o.y = pk2((a[4 * g + 2] + bp[2]) * bflo(gb.y), (a[4 * g + 3] + bp[3]) * bfhi(gb.y));
          *(u32x2*)(ym + n) = o;
        }
    }
  }
  __syncthreads();
}

DI void phase_mix(const Params& p, int l, char* lds) {
  constexpr int N_CONV = 1032, N_Q = 257 * 6, N_K = 256 * 4, N_VT = 4 * 256, N_SKV = 129 * 8, N_GATE = 1024, N_SG = 8;
  const bf16_t* z = (const bf16_t*)(p.ws + OFF_Z);
  const int G = gridDim.x;
  int base = 0;
  auto first = [&](int b) { const int r = (int)blockIdx.x - (b % G); return r < 0 ? r + G : r; };
  for (int v = first(base); v < N_CONV; v += G) conv_unit(p, l, v, lds);
  base += N_CONV;
  {
    EpiQ e{(bf16_t*)(p.ws + OFF_H), (const f32x2*)(p.ws + OFF_CS)};
    for (int v = first(base); v < N_Q; v += G)
      gemm_tile(z + ZC_CQ, ZLD, (const bf16_t*)(p.ws + OFF_WUQ) + (size_t)l * 768 * 384, 384, 384, (v / 6) * 128, (v % 6) * 128, lds, e);
  }
  base += N_Q;
  {
    EpiStore e{(bf16_t*)(p.ws + OFF_KP), 512};
    for (int v = first(base); v < N_K; v += G)
      gemm_tile(z + ZC_CKV, ZLD, (const bf16_t*)(p.ws + OFF_WUKV) + (size_t)l * 1024 * 256, 256, 256, (v / 4) * 128, (v % 4) * 128, lds, e);
  }
  base += N_K;
  {
    EpiVt e{(bf16_t*)(p.ws + OFF_VTP)};
    for (int v = first(base); v < N_VT; v += G)
      gemm_tile((const bf16_t*)(p.ws + OFF_WUKV) + (size_t)l * 1024 * 256 + 512 * 256, 256, z + ZC_CKV, ZLD, 256, (v & 3) * 128, (v >> 2) * 128, lds, e);
  }
  base += N_VT;
  {
    EpiStore e{(bf16_t*)(p.ws + OFF_KVS), 1024};
    for (int v = first(base); v < N_SKV; v += G)
      gemm_tile((const bf16_t*)(p.ws + OFF_LATS) + (size_t)l * SROWS * 256, 256, (const bf16_t*)(p.ws + OFF_WUKV) + (size_t)l * 1024 * 256, 256, 256, (v / 8) * 128, (v % 8) * 128, lds, e);
  }
  base += N_SKV;
  for (int v = first(base); v < N_GATE; v += G) gate_unit(p, l, v >> 2, v & 3, lds);
  base += N_GATE;
  for (int v = first(base); v < N_SG; v += G) sgate_unit(p, l, v);
}

constexpr int KROW = 208, VROWB = 144, KT_BYTES = 64 * KROW, ATT_STAGE = KT_BYTES + 64 * VROWB;

DI void attn_unit(const Params& p, int b, int h, int qt, char* lds) {
  const int tid = threadIdx.x, lane = tid & 63, w = tid >> 6;
  const bf16_t* z = (const bf16_t*)(p.ws + OFF_Z);
  const bf16_t* Q = (const bf16_t*)(p.ws + OFF_H);
  const bf16_t* Kp = (const bf16_t*)(p.ws + OFF_KP);
  const bf16_t* Vt = (const bf16_t*)(p.ws + OFF_VTP);
  const int nkt = 2 * qt + 2, my_nkt = 2 * qt + 1 + (w >> 1);
  const size_t trow = (size_t)b * SEQ + qt * 128 + w * 32 + (lane & 31);
  bf16x8 qf[6];
#pragma unroll
  for (int s = 0; s < 6; ++s) qf[s] = *(const bf16x8*)(Q + trow * 768 + h * 96 + s * 16 + (lane >> 5) * 8);
  const bf16_t* kg[3]; int klo[3];
#pragma unroll
  for (int i = 0; i < 3; ++i) {
    const int c = tid + 256 * i, key = c / 12, ch = c % 12;
    kg[i] = ch < 8 ? Kp + ((size_t)b * SEQ + key) * 512 + h * 64 + ch * 8 : z + ((size_t)b * SEQ + key) * ZLD + ZC_KR + (ch - 8) * 8;
    klo[i] = key * KROW + ch * 16;
  }
  const size_t kstep[3] = {(size_t)64 * ((tid % 12) < 8 ? 512 : ZLD), (size_t)64 * (((tid + 256) % 12) < 8 ? 512 : ZLD), (size_t)64 * (((tid + 512) % 12) < 8 ? 512 : ZLD)};
  const bf16_t* vg = Vt + ((size_t)(b * 8 + h) * 64 + (tid >> 3)) * SEQ + (tid & 7) * 8;
  const int vlo = KT_BYTES + (tid >> 3) * VROWB + (tid & 7) * 16;
  u32x4 rk[3], rv[2];
#pragma unroll
  for (int i = 0; i < 3; ++i) rk[i] = *(const u32x4*)(kg[i]);
  rv[0] = *(const u32x4*)(vg); rv[1] = *(const u32x4*)(vg + (size_t)32 * SEQ);
#pragma unroll
  for (int i = 0; i < 3; ++i) *(u32x4*)(lds + klo[i]) = rk[i];
  *(u32x4*)(lds + vlo) = rv[0]; *(u32x4*)(lds + vlo + 32 * VROWB) = rv[1];
  __syncthreads();
  f32x16 o0 = zero16(), o1 = zero16();
  float m = -1e30f, lsum = 0.f;
  const int kfo = (lane & 31) * KROW + (lane >> 5) * 16;
  const int vfo = KT_BYTES + (lane & 31) * VROWB + (lane >> 5) * 16;
  for (int kt = 0; kt < nkt; ++kt) {
    if (kt + 1 < nkt) {
#pragma unroll
      for (int i = 0; i < 3; ++i) rk[i] = *(const u32x4*)(kg[i] + (size_t)(kt + 1) * kstep[i]);
      rv[0] = *(const u32x4*)(vg + (kt + 1) * 64); rv[1] = *(const u32x4*)(vg + (size_t)32 * SEQ + (kt + 1) * 64);
    }
    if (kt < my_nkt) {
      const char* st = lds + (kt & 1) * ATT_STAGE;
      f32x16 s0 = zero16(), s1 = zero16();
#pragma unroll
      for (int s = 0; s < 6; ++s) {
        const bf16x8 k0 = *(const bf16x8*)(st + kfo + s * 32), k1 = *(const bf16x8*)(st + kfo + 32 * KROW + s * 32);
        s0 = mfma32(k0, qf[s], s0); s1 = mfma32(k1, qf[s], s1);
      }
      float mx = fmaxf(s0[0], s1[0]);
#pragma unroll
      for (int r = 1; r < 16; ++r) mx = fmaxf(mx, fmaxf(s0[r], s1[r]));
      mx = fmaxf(mx, __shfl_xor(mx, 32));
      const float mn = fmaxf(m, mx);
      const float alpha = __builtin_amdgcn_exp2f(m - mn);
      m = mn;
      float rs = 0.f;
#pragma unroll
      for (int r = 0; r < 16; ++r) { s0[r] = __builtin_amdgcn_exp2f(s0[r] - mn); s1[r] = __builtin_amdgcn_exp2f(s1[r] - mn); rs += s0[r] + s1[r]; }
      lsum = lsum * alpha + rs;
      o0 *= alpha; o1 *= alpha;
#pragma unroll
      for (int kb = 0; kb < 2; ++kb)
#pragma unroll
        for (int ks = 0; ks < 2; ++ks) {
          const f32x16& sv = kb ? s1 : s0;
          u32x4 pw;
          pw.x = pk2(sv[8 * ks + 0], sv[8 * ks + 1]); pw.y = pk2(sv[8 * ks + 2], sv[8 * ks + 3]);
          pw.z = pk2(sv[8 * ks + 4], sv[8 * ks + 5]); pw.w = pk2(sv[8 * ks + 6], sv[8 * ks + 7]);
          const bf16x8 pf = __builtin_bit_cast(bf16x8, pw);
          const bf16x8 v0 = *(const bf16x8*)(st + vfo + (32 * kb + 16 * ks) * 2), v1 = *(const bf16x8*)(st + vfo + 32 * VROWB + (32 * kb + 16 * ks) * 2);
          o0 = mfma32(v0, pf, o0); o1 = mfma32(v1, pf, o1);
        }
    }
    if (kt + 1 < nkt) {
      char* st = lds + ((kt + 1) & 1) * ATT_STAGE;
#pragma unroll
      for (int i = 0; i < 3; ++i) *(u32x4*)(st + klo[i]) = rk[i];
      *(u32x4*)(st + vlo) = rv[0]; *(u32x4*)(st + vlo + 32 * VROWB) = rv[1];
    }
    __syncthreads();
  }
  lsum += __shfl_xor(lsum, 32);
  const float inv = 1.0f / lsum;
  const int hh = lane >> 5;
  const bf16_t* gc = z + trow * ZLD + ZC_GC + h * 64;
  bf16_t* ym = (bf16_t*)(p.ws + OFF_YMIX) + trow * 1024 + 512 + h * 64;
#pragma unroll
  for (int db = 0; db < 2; ++db)
#pragma unroll
    for (int g = 0; g < 4; ++g) {
      const int d = db * 32 + 8 * g + 4 * hh;
      const u32x2 gv = *(const u32x2*)(gc + d);
      const f32x16& o = db ? o1 : o0;
      u32x2 wv;
      wv.x = pk2(o[4 * g] * inv * bflo(gv.x), o[4 * g + 1] * inv * bfhi(gv.x));
      wv.y = pk2(o[4 * g + 2] * inv * bflo(gv.y), o[4 * g + 3] * inv * bfhi(gv.y));
      *(u32x2*)(ym + d) = wv;
    }
}

DI void sattn_unit(const Params& p, int l, int b, int h, char* lds) {
  const int tid = threadIdx.x, lane = tid & 63, w = tid >> 6;
  const bf16_t* z = (const bf16_t*)(p.ws + OFF_Z);
  const bf16_t* Q = (const bf16_t*)(p.ws + OFF_H);
  const bf16_t* kvs = (const bf16_t*)(p.ws + OFF_KVS) + (size_t)b * SKV * 1024;
  const bf16_t* krs = (const bf16_t*)(p.ws + OFF_KRS) + (size_t)(l * 8 + b) * SKV * 32;
  float* sc = (float*)(p.ws + OFF_SSCR) + (size_t)(b * 8 + h) * SKV * 16;
  float* qs = (float*)lds;
  float* red = qs + 96 * 16;
  float* stat = red + 64;
  for (int e = tid; e < 16 * 96; e += 256) {
    const int i = e / 96, d = e % 96;
    qs[d * 16 + i] = bf2f(Q[(size_t)(TP + b * 16 + i) * 768 + h * 96 + d]);
  }
  __syncthreads();
  float mx[16];
#pragma unroll
  for (int i = 0; i < 16; ++i) mx[i] = -1e30f;
  for (int k = tid; k < SKV; k += 256) {
    float a[16];
#pragma unroll
    for (int i = 0; i < 16; ++i) a[i] = 0.f;
#pragma unroll 1
    for (int c = 0; c < 12; ++c) {
      const u32x4 raw = c < 8 ? *(const u32x4*)(kvs + (size_t)k * 1024 + h * 64 + c * 8) : *(const u32x4*)(krs + (size_t)k * 32 + (c - 8) * 8);
      const float kv[8] = {bflo(raw.x), bfhi(raw.x), bflo(raw.y), bfhi(raw.y), bflo(raw.z), bfhi(raw.z), bflo(raw.w), bfhi(raw.w)};
#pragma unroll
      for (int e = 0; e < 8; ++e) {
        const float* qp = qs + (c * 8 + e) * 16;
#pragma unroll
        for (int i4 = 0; i4 < 4; ++i4) {
          const f32x4 qv = *(const f32x4*)(qp + i4 * 4);
          a[i4 * 4 + 0] += kv[e] * qv[0]; a[i4 * 4 + 1] += kv[e] * qv[1]; a[i4 * 4 + 2] += kv[e] * qv[2]; a[i4 * 4 + 3] += kv[e] * qv[3];
        }
      }
    }
#pragma unroll
    for (int i4 = 0; i4 < 4; ++i4) *(f32x4*)(sc + (size_t)k * 16 + i4 * 4) = (f32x4){a[i4 * 4], a[i4 * 4 + 1], a[i4 * 4 + 2], a[i4 * 4 + 3]};
#pragma unroll
    for (int i = 0; i < 16; ++i) mx[i] = fmaxf(mx[i], a[i]);
  }
#pragma unroll
  for (int i = 0; i < 16; ++i) {
    float v = mx[i];
#pragma unroll
    for (int o = 32; o > 0; o >>= 1) v = fmaxf(v, __shfl_xor(v, o));
    if (lane == 0) red[w * 16 + i] = v;
  }
  __syncthreads();
  if (tid < 16) stat[tid] = fmaxf(fmaxf(red[tid], red[16 + tid]), fmaxf(red[32 + tid], red[48 + tid]));
  __syncthreads();
  float sm[16];
#pragma unroll
  for (int i = 0; i < 16; ++i) sm[i] = 0.f;
  for (int k = tid; k < SKV; k += 256) {
#pragma unroll
    for (int i4 = 0; i4 < 4; ++i4) {
      f32x4 v = *(const f32x4*)(sc + (size_t)k * 16 + i4 * 4);
#pragma unroll
      for (int e = 0; e < 4; ++e) { v[e] = __builtin_amdgcn_exp2f(v[e] - stat[i4 * 4 + e]); sm[i4 * 4 + e] += v[e]; }
      *(f32x4*)(sc + (size_t)k * 16 + i4 * 4) = v;
    }
  }
  __syncthreads();
#pragma unroll
  for (int i = 0; i < 16; ++i) {
    const float v = wsum(sm[i]);
    if (lane == 0) red[w * 16 + i] = v;
  }
  __syncthreads();
  if (tid < 16) stat[16 + tid] = (red[tid] + red[16 + tid]) + (red[32 + tid] + red[48 + tid]);
  __syncthreads();
  float o[4] = {0.f, 0.f, 0.f, 0.f};
  const bf16_t* vp = kvs + 512 + h * 64 + lane;
#pragma unroll 4
  for (int k = 0; k < SKV; ++k) {
    const f32x4 pv = *(const f32x4*)(sc + (size_t)k * 16 + w * 4);
    const float vv = bf2f(vp[(size_t)k * 1024]);
    o[0] += pv[0] * vv; o[1] += pv[1] * vv; o[2] += pv[2] * vv; o[3] += pv[3] * vv;
  }
#pragma unroll
  for (int e = 0; e < 4; ++e) {
    const int t = TP + b * 16 + w * 4 + e;
    const float gcv = bf2f(z[(size_t)t * ZLD + ZC_GC + h * 64 + lane]);
    ((bf16_t*)(p.ws + OFF_YMIX))[(size_t)t * 1024 + 512 + h * 64 + lane] = f2bf(o[e] / stat[16 + w * 4 + e] * gcv);
  }
  __syncthreads();
}

DI void phase_attn(const Params& p, int l, char* lds) {
  const int G = gridDim.x;
  for (int u = blockIdx.x; u < 64; u += G) sattn_unit(p, l, u >> 3, u & 7, lds);
  int v0 = (int)blockIdx.x - (64 % G); if (v0 < 0) v0 += G;
  for (int pr = v0; pr < 1024; pr += G) {
    const int bh = pr & 15, q = pr >> 4;
    attn_unit(p, bh >> 3, bh & 7, 127 - q, lds);
    attn_unit(p, bh >> 3, bh & 7, q, lds);
  }
}

struct EpiOut {
  const float* xa; const float* xb; float* r; const float* mod;
  DI void operator()(int m, int nb, int hh, const f32x16& acc) const {
    const float* xr = m < TP ? xa + (size_t)m * 1024 : xb + (size_t)(m - TP) * 1024;
    const float* gate = mod + (size_t)mod_row(m) * 3072 + 2048;
#pragma unroll
    for (int g = 0; g < 4; ++g) {
      const int n = nb + 8 * g + 4 * hh;
      const f32x4 xv = *(const f32x4*)(xr + n), gv = *(const f32x4*)(gate + n);
      f32x4 o;
      o[0] = ALPHA * xv[0] + gv[0] * acc[4 * g]; o[1] = ALPHA * xv[1] + gv[1] * acc[4 * g + 1];
      o[2] = ALPHA * xv[2] + gv[2] * acc[4 * g + 2]; o[3] = ALPHA * xv[3] + gv[3] * acc[4 * g + 3];
      *(f32x4*)(r + (size_t)m * 1024 + n) = o;
    }
  }
};
DI void phase_out(const Params& p, int l, char* lds) {
  EpiOut e;
  if (l == 0) { e.xa = p.x_prompt; e.xb = p.x_sample; } else { e.xa = p.out; e.xb = p.out + (size_t)TP * 1024; }
  e.r = (float*)(p.ws + OFF_Z);
  e.mod = (const float*)(p.ws + OFF_MOD) + (size_t)l * 10 * 3072;
  const bf16_t* ym = (const bf16_t*)(p.ws + OFF_YMIX);
  const bf16_t* wt = (const bf16_t*)(p.ws + OFF_WOUT) + (size_t)l * 1024 * 1024;
  for (int u = blockIdx.x; u < 257 * 8; u += gridDim.x) gemm_tile(ym, 1024, wt, 1024, 1024, (u >> 3) * 128, (u & 7) * 128, lds, e);
}

template <int L>
DI void layer_phases(const Params& p, char* lds, cg::grid_group& grid) {
  phase_ln(p, L);
  grid.sync();
  phase_zgemm(p, L, lds);
  grid.sync();
  phase_rows(p, L);
  grid.sync();
  phase_mix(p, L, lds);
  grid.sync();
  phase_attn(p, L, lds);
  grid.sync();
  phase_out(p, L, lds);
  grid.sync();
}

__global__ void __launch_bounds__(256, 2) fwd_megakernel(Params p) {
  __shared__ __attribute__((aligned(16))) char lds[LDS_BYTES];
  cg::grid_group grid = cg::this_grid();
  phase_prep(p, lds);
  grid.sync();
  layer_phases<0>(p, lds, grid);
  layer_phases<1>(p, lds, grid);
  phase_ln(p, 2);
}

extern "C" void kernel_launch(void* const* d_in, const int* in_sizes, int n_in, void* d_out, int out_size, void* d_ws, size_t ws_size, hipStream_t stream) {
  static int grid_blocks = 0;
  if (!grid_blocks) {
    int dev = 0, cus = 0, per_cu = 0;
    hipGetDevice(&dev);
    hipDeviceGetAttribute(&cus, hipDeviceAttributeMultiprocessorCount, dev);
    hipOccupancyMaxActiveBlocksPerMultiprocessor(&per_cu, fwd_megakernel, 256, 0);
    if (per_cu > 2) per_cu = 2;
    if (per_cu < 1) per_cu = 1;
    grid_blocks = cus * per_cu;
  }
  if (ws_size < WS_NEED) { fprintf(stderr, "workspace too small: %zu < %zu\n", ws_size, (size_t)WS_NEED); return; }
  Params p{};
  const float** f = (const float**)&p;
  for (int i = 0; i < 27; ++i) f[i] = (const float*)d_in[i];
  p.out = (float*)d_out;
  p.ws = (char*)d_ws;
  void* args[] = {&p};
  hipError_t e = hipLaunchCooperativeKernel((void*)fwd_megakernel, dim3(grid_blocks), dim3(256), args, 0, stream);
  if (e != hipSuccess) fprintf(stderr, "cooperative launch failed: %s (grid %d)\n", hipGetErrorString(e), grid_blocks);
}
```

```cpp
#include <hip/hip_runtime.h>
#include <hip/hip_cooperative_groups.h>
#include <cstdio>
#include <cstdint>
namespace cg = cooperative_groups;

#define DI __device__ __forceinline__
typedef unsigned short bf16_t;
typedef short bf16x8 __attribute__((ext_vector_type(8)));
typedef float f32x16 __attribute__((ext_vector_type(16)));
typedef float f32x4 __attribute__((ext_vector_type(4)));
typedef float f32x2 __attribute__((ext_vector_type(2)));
typedef __bf16 bf16x2_t __attribute__((ext_vector_type(2)));
typedef unsigned u32x4 __attribute__((ext_vector_type(4)));
typedef unsigned u32x2 __attribute__((ext_vector_type(2)));

constexpr int TP = 32768, TS = 128, T = TP + TS, SEQ = 16384, DM = 1024;
constexpr int PAST = 2048, SKV = PAST + 16;
constexpr int SKVP = 2112;
constexpr int SROWS = 8 * SKVP;
constexpr int NTH = 512;
constexpr int ZLD = 2816;
constexpr int ZC_U = 0, ZC_V = 256, ZC_GA = 512, ZC_GLU = 768, ZC_GB = 1280, ZC_CQ = 1536, ZC_CKV = 1920, ZC_GC = 2176, ZC_KR = 2688;
constexpr float LN_EPS = 1e-5f, RMS_EPS = 1e-6f;
constexpr float ALPHA = 1.41421356237309515f;
constexpr float QSCALE = 0.10206207261596577f * 1.4426950408889634f;

constexpr size_t O_YP = 0, O_YS = 33554432, O_PCONV = 33685504, O_PLAT = 33716224, O_PKR = 50493440,
                 O_SCONV = 52590592, O_SLAT = 52713472, O_SKR = 52779008, O_SV = 52787200;

constexpr size_t al256(size_t x) { return (x + 255) & ~(size_t)255; }
constexpr size_t OFF_WIN = 0;
constexpr size_t OFF_WUQ = OFF_WIN + al256((size_t)2 * 2816 * 1024 * 2);
constexpr size_t OFF_WUKV = OFF_WUQ + al256((size_t)2 * 768 * 384 * 2);
constexpr size_t OFF_WOUT = OFF_WUKV + al256((size_t)2 * 1024 * 256 * 2);
constexpr size_t OFF_WPW = OFF_WOUT + al256((size_t)2 * 1024 * 1024 * 2);
constexpr size_t OFF_WSB = OFF_WPW + al256((size_t)2 * 256 * 256 * 2);
constexpr size_t OFF_MOD = OFF_WSB + al256((size_t)2 * 4 * 128 * 128 * 2);
constexpr size_t OFF_CS = OFF_MOD + al256((size_t)2 * 10 * 3072 * 4);
constexpr size_t OFF_Z = OFF_CS + al256((size_t)16384 * 16 * 8);
constexpr size_t OFF_H = OFF_Z + al256((size_t)T * ZLD * 2);
constexpr size_t OFF_YMIX = OFF_H + al256((size_t)T * 1024 * 2);
constexpr size_t OFF_KP = OFF_YMIX + al256((size_t)T * 1024 * 2);
constexpr size_t OFF_VTP = OFF_KP + al256((size_t)TP * 512 * 2);
constexpr size_t OFF_LATS = OFF_VTP + al256((size_t)TP * 512 * 2);
constexpr size_t OFF_KRS = OFF_LATS + al256((size_t)2 * SROWS * 256 * 2);
constexpr size_t OFF_KS = OFF_KRS + al256((size_t)2 * SROWS * 32 * 2);
constexpr size_t OFF_VTS = OFF_KS + al256((size_t)SROWS * 512 * 2);
constexpr size_t OFF_KRP = OFF_VTS + al256((size_t)512 * SROWS * 2);
constexpr size_t OFF_BAR = OFF_KRP + al256((size_t)TP * 32 * 2);
constexpr size_t OFF_STATS = OFF_BAR + 16384;
constexpr size_t WS_NEED = OFF_STATS + al256((size_t)T * 2 * 4);

struct Params {
  const float *x_prompt, *x_sample, *cache_latent, *cache_krope, *state_conv, *c_prompt, *c_sample;
  const float *w_ada, *b_ada, *w_in, *gmlp_ln_g, *gmlp_ln_b, *gmlp_ws, *gmlp_bs, *conv_dw_k, *conv_dw_b, *conv_ln_g, *conv_ln_b,
      *conv_w_pw, *conv_b_pw, *mla_q_norm, *mla_w_uq, *mla_kv_norm, *mla_w_ukv, *w_out, *post_ln_g, *post_ln_b;
  float* out;
  char* ws;
};

DI unsigned pk2(float a, float b) { f32x2 v = {a, b}; return __builtin_bit_cast(unsigned, __builtin_convertvector(v, bf16x2_t)); }
DI bf16_t f2bf(float a) { return (bf16_t)(pk2(a, 0.f) & 0xffffu); }
DI float bflo(unsigned u) { return __uint_as_float(u << 16); }
DI float bfhi(unsigned u) { return __uint_as_float(u & 0xffff0000u); }
DI float bf2f(bf16_t v) { return __uint_as_float((unsigned)v << 16); }
DI float sigmoidf_(float x) { return __builtin_amdgcn_rcpf(1.0f + __builtin_amdgcn_exp2f(-1.4426950408889634f * x)); }
DI float siluf_(float x) { return x * sigmoidf_(x); }
DI float geluf_(float x) { const float y = x * (0.7978845608028654f + 0.0356774081363001f * x * x); return x * sigmoidf_(2.0f * y); }
DI float wsum(float v) {
#pragma unroll
  for (int o = 32; o > 0; o >>= 1) v += __shfl_xor(v, o);
  return v;
}
DI f32x16 mfma32(bf16x8 a, bf16x8 b, f32x16 c) { return __builtin_amdgcn_mfma_f32_32x32x16_bf16(a, b, c, 0, 0, 0); }
DI f32x16 zero16() { f32x16 z; for (int i = 0; i < 16; ++i) z[i] = 0.f; return z; }
DI int swap23(int x) { return (x & ~12) | ((x & 4) << 1) | ((x & 8) >> 1); }
DI int mod_row(int t) { return t < TP ? (t >> 14) : 2 + ((t - TP) >> 4); }
DI int tok_pos(int t) { return t < TP ? (t & (SEQ - 1)) : PAST + ((t - TP) & 15); }

DI int otid() { int t = threadIdx.x; asm volatile("" : "+v"(t)); return t; }

template <class Epi> DI int epi_tag(const Epi& e, int colblk) { if constexpr (Epi::TAGGED) return e.tag(colblk); else return 0; }
template <class Epi> DI void epi_quad(const Epi& e, int row, int col, f32x4 v, int tag) { if constexpr (Epi::TAGGED) e.quad(row, col, v, tag); else e.quad(row, col, v); }
template <class Epi> DI void epi_rope(const Epi& e, int row, int colblk, int i0, f32x4 x1, f32x4 x2) { if constexpr (Epi::ROPE) e.rope(row, colblk, i0, x1, x2); }

namespace g256 {
constexpr int BK = 64, HALF = 128, HT = HALF * BK;
DI int lds_byte(int r, int c) { const int st = (r >> 4) * 2 + (c >> 5), rr = r & 15, cc = c & 31, ob = rr * 64 + cc * 2; return st * 1024 + (ob ^ (((ob >> 9) & 1) << 5)); }
DI void stage_rc(int b, int& R, int& C) { const int st = b / 1024, sb = b % 1024, swz = sb ^ (((sb >> 9) & 1) << 5); R = (st >> 1) * 16 + swz / 64; C = (st & 1) * 32 + (swz % 64) / 2; }

#define LAS __attribute__((address_space(3)))
DI bool unit_of(int L, int nM, int nN, int& pm, int& pn) {
  const int nwg = nM * nN;
  if (L >= nwg) return false;
  int wgid = L;
  { const int q = nwg / 8, r = nwg % 8, xcd = wgid % 8, off = wgid / 8; wgid = (xcd < r ? xcd * (q + 1) : r * (q + 1) + (xcd - r) * q) + off; }
  const int nig = 8 * nN, gid = wgid / nig, fm = gid * 8, gsz = (nM - fm) < 8 ? (nM - fm) : 8;
  pm = fm + ((wgid % nig) % gsz); pn = (wgid % nig) / gsz;
  return true;
}
template <class Epi>
DI void phase(const bf16_t* __restrict__ A, int lda, const bf16_t* __restrict__ Bt, int ldb, int K, int M, int N, int first, char* shmc, const Epi& epi) {
  const int nM = M / 256, nN = N / 256, G = gridDim.x;
  int L = first, pm, pn;
  if (!unit_of(L, nM, nN, pm, pn)) return;
  LAS unsigned char* lds = (LAS unsigned char*)shmc;
  int tidv = threadIdx.x;
  asm volatile("" : "+v"(tidv));
  constexpr int HTB = HT * 2;
#define SA(b, h) (((b) * 2 + (h)) * HTB)
#define SB(b, h) ((4 + (b) * 2 + (h)) * HTB)
#define STAGE(bufoff, gbase, voff) do { _Pragma("unroll") for (int _i = 0; _i < 2; ++_i) \
    __builtin_amdgcn_global_load_lds((const unsigned*)((const char*)(gbase) + (voff)[_i]), (LAS unsigned*)(lds + (bufoff) + ldsw + _i * 8192), 16, 0, 0); } while (0)
#define LDA(dst, b, h) do { _Pragma("unroll") for (int m = 0; m < 4; ++m) _Pragma("unroll") for (int k = 0; k < 2; ++k) dst[m][k] = *(const LAS bf16x8*)(lds + SA(b, h) + aoff + m * 2048 + k * 1024); } while (0)
#define LDB(dst, b, h) do { _Pragma("unroll") for (int n = 0; n < 2; ++n) _Pragma("unroll") for (int k = 0; k < 2; ++k) dst[n][k] = *(const LAS bf16x8*)(lds + SB(b, h) + boff + n * 2048 + k * 1024); } while (0)
#define MMA(ai, bj, At_, Bt_) do { __builtin_amdgcn_s_setprio(1); _Pragma("unroll") for (int m = 0; m < 4; ++m) _Pragma("unroll") for (int n = 0; n < 2; ++n) _Pragma("unroll") for (int k = 0; k < 2; ++k) \
      acc[ai][bj][m][n] = __builtin_amdgcn_mfma_f32_16x16x32_bf16(Bt_[n][k], At_[m][k], acc[ai][bj][m][n], 0, 0, 0); \
    __builtin_amdgcn_s_setprio(0); } while (0)
#define WAIT_V(n) asm volatile("s_waitcnt vmcnt(" #n ")" ::: "memory")
#define WAIT_L(n) asm volatile("s_waitcnt lgkmcnt(" #n ")" ::: "memory")
#define BAR __builtin_amdgcn_s_barrier()
#define SCHED __builtin_amdgcn_sched_barrier(0)
  const int wid = __builtin_amdgcn_readfirstlane(tidv >> 6), lane = tidv & 63, wr = wid >> 2, wc = wid & 3, fr = lane & 15, fq = lane >> 4;
  const int aoff = lds_byte(wr * 64 + fr, fq * 8), boff = lds_byte(wc * 32 + fr, fq * 8);
  const unsigned ldsw = (unsigned)wid * 1024u;
  unsigned voffA[2], voffB[2];
#pragma unroll
  for (int i = 0; i < 2; ++i) { int R, C; stage_rc(tidv * 16 + i * 8192, R, C); voffA[i] = (unsigned)(R * lda + C) * 2u; voffB[i] = (unsigned)(R * ldb + C) * 2u; }
  const size_t hA = (size_t)HALF * lda * 2, hB = (size_t)HALF * ldb * 2;
  const char* cA = (const char*)A + (size_t)pm * 2 * hA; const char* cB = (const char*)Bt + (size_t)pn * 2 * hB;
  constexpr int kstep = BK * 2;
  f32x4 acc[2][2][4][2];
#pragma unroll
  for (int i = 0; i < 2; ++i)
#pragma unroll
    for (int j = 0; j < 2; ++j)
#pragma unroll
      for (int m = 0; m < 4; ++m)
#pragma unroll
        for (int n = 0; n < 2; ++n) acc[i][j][m][n] = (f32x4){0.f, 0.f, 0.f, 0.f};
  bf16x8 At[4][2], B0[2][2], B1[2][2];
  const int nt = K / BK;
  STAGE(SB(0, 0), cB, voffB); STAGE(SB(0, 1), cB + hB, voffB); STAGE(SA(0, 0), cA, voffA); STAGE(SA(0, 1), cA + hA, voffA);
  if (wr == 1) BAR;
  WAIT_V(2); BAR;
  STAGE(SB(1, 0), cB + kstep, voffB); STAGE(SA(1, 0), cA + kstep, voffA); STAGE(SB(1, 1), cB + hB + kstep, voffB);
  WAIT_V(6); BAR;
  for (;;) {
    int npm, npn;
    const bool has_next = unit_of(L + G, nM, nN, npm, npn);
    const char* nA = has_next ? (const char*)A + (size_t)npm * 2 * hA : cA; const char* nB = has_next ? (const char*)Bt + (size_t)npn * 2 * hB : cB;
    for (int t = 0; t < nt; t += 2) {
      const bool last = (t == nt - 2);
      const char* a1 = cA + (size_t)(t + 1) * kstep;
      const char* a2 = last ? nA : cA + (size_t)(t + 2) * kstep; const char* b2 = last ? nB : cB + (size_t)(t + 2) * kstep;
      const char* a3 = a2 + kstep; const char* b3 = b2 + kstep;
      LDB(B0, 0, 0); LDB(B1, 0, 1); SCHED; LDA(At, 0, 0); STAGE(SA(1, 1), a1 + hA, voffA);
      WAIT_V(8); WAIT_L(0); BAR; MMA(0, 0, At, B0); MMA(0, 1, At, B1); BAR; SCHED;
      LDA(At, 0, 1); STAGE(SB(0, 0), b2, voffB); STAGE(SB(0, 1), b2 + hB, voffB); STAGE(SA(0, 0), a2, voffA);
      WAIT_V(8); WAIT_L(0); BAR; MMA(1, 0, At, B0); MMA(1, 1, At, B1); BAR; SCHED;
      LDB(B0, 1, 0); LDB(B1, 1, 1); SCHED; LDA(At, 1, 0); STAGE(SA(0, 1), a2 + hA, voffA);
      WAIT_V(8); WAIT_L(0); BAR; MMA(0, 0, At, B0); MMA(0, 1, At, B1); BAR; SCHED;
      LDA(At, 1, 1); STAGE(SB(1, 0), b3, voffB); STAGE(SB(1, 1), b3 + hB, voffB); STAGE(SA(1, 0), a3, voffA);
      WAIT_V(8); WAIT_L(0); BAR; MMA(1, 0, At, B0); MMA(1, 1, At, B1); BAR; SCHED;
    }
    const int brow = pm * 256, bcol = pn * 256;
#pragma unroll
    for (int ai = 0; ai < 2; ++ai)
#pragma unroll
      for (int bj = 0; bj < 2; ++bj) {
        const int colblk = bcol + bj * HALF + wc * 32;
        const int tag = epi_tag(epi, colblk);
#pragma unroll
        for (int m = 0; m < 4; ++m) {
          const int row = brow + ai * HALF + wr * 64 + m * 16 + fr;
          if (Epi::ROPE && (colblk % 96) == 64) epi_rope(epi, row, colblk, fq * 4, acc[ai][bj][m][0], acc[ai][bj][m][1]);
          else { epi_quad(epi, row, colblk + fq * 4, acc[ai][bj][m][0], tag); epi_quad(epi, row, colblk + 16 + fq * 4, acc[ai][bj][m][1], tag); }
        }
      }
    if (!has_next) break;
#pragma unroll
    for (int i = 0; i < 2; ++i)
#pragma unroll
      for (int j = 0; j < 2; ++j)
#pragma unroll
        for (int m = 0; m < 4; ++m)
#pragma unroll
          for (int n = 0; n < 2; ++n) acc[i][j][m][n] = (f32x4){0.f, 0.f, 0.f, 0.f};
    pm = npm; pn = npn; cA = nA; cB = nB; L += G;
  }
  WAIT_V(0);
  if (wr == 0) BAR;
  BAR;
#undef SA
#undef SB
#undef STAGE
#undef LDA
#undef LDB
#undef MMA
#undef WAIT_V
#undef WAIT_L
#undef BAR
#undef SCHED
}
}

constexpr int GROW = 144;
constexpr int GA_T = 128 * GROW, GB_T = 256 * GROW, GSTAGE = GA_T + GB_T;
constexpr int LDS_BYTES = 131072;

template <class Epi>
DI void gemm_tile8(const bf16_t* __restrict__ A, int lda, const bf16_t* __restrict__ Bt, int ldb, int K, int m0, int n0, char* lds, const Epi& epi) {
  const int tx = otid();
  const int tid = tx, lane = tid & 63, w = __builtin_amdgcn_readfirstlane(tid >> 6), wm = w >> 2, wn = w & 3;
  const int lrow = tid >> 3, lkc = tid & 7;
  const bf16_t* ag = A + (size_t)(m0 + lrow) * lda + lkc * 8;
  const bf16_t* bg = Bt + (size_t)(n0 + lrow) * ldb + lkc * 8;
  u32x4 ra0[2], rb0[4], ra1[2], rb1[4];
#define T8_GLOAD(RA, RB, kt) do { _Pragma("unroll") for (int i = 0; i < 2; ++i) RA[i] = *(const u32x4*)(ag + (size_t)(64 * i) * lda + (kt) * 64); \
    _Pragma("unroll") for (int i = 0; i < 4; ++i) RB[i] = *(const u32x4*)(bg + (size_t)(64 * i) * ldb + (kt) * 64); } while (0)
#define T8_LSTORE(RA, RB, st) do { char* lw_ = lds + (st) * GSTAGE + lrow * GROW + lkc * 16; _Pragma("unroll") for (int i = 0; i < 2; ++i) *(u32x4*)(lw_ + 64 * i * GROW) = RA[i]; \
    _Pragma("unroll") for (int i = 0; i < 4; ++i) *(u32x4*)(lw_ + GA_T + 64 * i * GROW) = RB[i]; } while (0)
  const int nk = K >> 6;
  T8_GLOAD(ra0, rb0, 0);
  T8_GLOAD(ra1, rb1, 1);
  T8_LSTORE(ra0, rb0, 0);
  __syncthreads();
  f32x16 acc[2][2];
#pragma unroll
  for (int i = 0; i < 2; ++i)
#pragma unroll
    for (int j = 0; j < 2; ++j) acc[i][j] = zero16();
  const int fro = (lane & 31) * GROW + (lane >> 5) * 16;
#define T8_MMA(st) do { const char* sa = lds + (st) * GSTAGE + wm * 64 * GROW + fro; const char* sb = lds + (st) * GSTAGE + GA_T + wn * 64 * GROW + fro; \
    _Pragma("unroll") for (int s = 0; s < 4; ++s) { \
      const bf16x8 a0 = *(const bf16x8*)(sa + s * 32), a1 = *(const bf16x8*)(sa + 32 * GROW + s * 32); \
      const bf16x8 b0 = *(const bf16x8*)(sb + s * 32), b1 = *(const bf16x8*)(sb + 32 * GROW + s * 32); \
      acc[0][0] = mfma32(b0, a0, acc[0][0]); acc[0][1] = mfma32(b1, a0, acc[0][1]); acc[1][0] = mfma32(b0, a1, acc[1][0]); acc[1][1] = mfma32(b1, a1, acc[1][1]); } } while (0)
  for (int kt = 0; kt < nk; kt += 2) {
    if (kt + 2 < nk) T8_GLOAD(ra0, rb0, kt + 2);
    __builtin_amdgcn_sched_barrier(0);
    T8_MMA(0);
    __builtin_amdgcn_sched_barrier(0);
    T8_LSTORE(ra1, rb1, 1);
    __syncthreads();
    if (kt + 3 < nk) T8_GLOAD(ra1, rb1, kt + 3);
    __builtin_amdgcn_sched_barrier(0);
    T8_MMA(1);
    __builtin_amdgcn_sched_barrier(0);
    if (kt + 2 < nk) T8_LSTORE(ra0, rb0, 0);
    __syncthreads();
  }
#undef T8_GLOAD
#undef T8_LSTORE
#undef T8_MMA
  const int hh = lane >> 5;
#pragma unroll
  for (int i = 0; i < 2; ++i)
#pragma unroll
    for (int j = 0; j < 2; ++j) {
      const int row = m0 + wm * 64 + i * 32 + (lane & 31), nb = n0 + wn * 64 + j * 32;
      const f32x16& a = acc[i][j];
      if (Epi::ROPE && (nb % 96) == 64) {
#pragma unroll
        for (int g = 0; g < 2; ++g)
          epi_rope(epi, row, nb, 8 * g + 4 * hh, (f32x4){a[4 * g], a[4 * g + 1], a[4 * g + 2], a[4 * g + 3]}, (f32x4){a[4 * g + 8], a[4 * g + 9], a[4 * g + 10], a[4 * g + 11]});
      } else {
#pragma unroll
        for (int g = 0; g < 4; ++g) epi_quad(epi, row, nb + 8 * g + 4 * hh, (f32x4){a[4 * g], a[4 * g + 1], a[4 * g + 2], a[4 * g + 3]}, epi_tag(epi, nb));
      }
    }
}

DI void transpose_unit(const float* __restrict__ src, int lds_src, bf16_t* __restrict__ dst, int K, int k0, int n0, int kind, char* lds, int tid) {
  float* tile = (float*)lds;
  const int nn = tid & 63, kq = tid >> 6;
  const int np = n0 + nn;
  int sc;
  if (kind == 0) { sc = np < 2176 ? np : (np < 2688 ? np + 32 : (np < 2720 ? np - 512 : -1)); }
  else if (kind == 2) { sc = np < 512 ? ((np >> 6) * 128 + (np & 63)) : (((np - 512) >> 6) * 128 + 64 + (np & 63)); }
  else sc = np;
#pragma unroll 4
  for (int i = 0; i < 16; ++i) {
    const int kk = kq * 16 + i;
    tile[kk * 65 + nn] = sc >= 0 ? src[(size_t)(k0 + kk) * lds_src + sc] : 0.f;
  }
  __syncthreads();
  const int kk = tid & 63, nq = tid >> 6;
#pragma unroll 4
  for (int i = 0; i < 16; ++i) {
    const int n2 = nq * 16 + i;
    dst[(size_t)(n0 + n2) * K + k0 + kk] = f2bf(tile[kk * 65 + n2]);
  }
  __syncthreads();
}

DI void mod_unit(const Params& p, int l, int cg0, char* lds, int tid) {
  float* sc = (float*)lds;
  float* red = sc + 10 * 1024;
  for (int e = tid; e < 10 * 1024; e += 256) {
    const int r = e >> 10, k = e & 1023;
    const float c = r < 2 ? p.c_prompt[r * 1024 + k] : p.c_sample[(r - 2) * 1024 + k];
    sc[e] = siluf_(c);
  }
  __syncthreads();
  const int col = cg0 * 32 + (tid & 31), kg = tid >> 5;
  float acc[10];
#pragma unroll
  for (int r = 0; r < 10; ++r) acc[r] = 0.f;
  const float* wp = p.w_ada + (size_t)l * 1024 * 3072 + col;
  for (int k = kg * 128; k < kg * 128 + 128; ++k) {
    const float wv = wp[(size_t)k * 3072];
#pragma unroll
    for (int r = 0; r < 10; ++r) acc[r] += sc[r * 1024 + k] * wv;
  }
#pragma unroll
  for (int r = 0; r < 10; ++r) red[(kg * 10 + r) * 32 + (tid & 31)] = acc[r];
  __syncthreads();
  float* mod = (float*)(p.ws + OFF_MOD);
  for (int e = tid; e < 320; e += 256) {
    const int r = e >> 5, c = e & 31;
    float s = 0.f;
#pragma unroll
    for (int g = 0; g < 8; ++g) s += red[(g * 10 + r) * 32 + c];
    mod[((size_t)l * 10 + r) * 3072 + cg0 * 32 + c] = s + p.b_ada[l * 3072 + cg0 * 32 + c];
  }
  __syncthreads();
}

DI void prep_weights(const Params& p, int l, int j, int nwg, char* lds) {
  const int tx = otid();
  constexpr int PER_L = 704 + 72 + 64 + 256 + 16;
  const int half = tx >> 8, tid = tx & 255;
  char* hl = lds + half * 65536;
  for (int up = j; up < PER_L / 2; up += nwg) {
    int v = up * 2 + half;
    if (v < 704) { transpose_unit(p.w_in + (size_t)l * 1024 * 2720, 2720, (bf16_t*)(p.ws + OFF_WIN) + (size_t)l * 2816 * 1024, 1024, (v % 16) * 64, (v / 16) * 64, 0, hl, tid); continue; }
    v -= 704;
    if (v < 72) { transpose_unit(p.mla_w_uq + (size_t)l * 384 * 768, 768, (bf16_t*)(p.ws + OFF_WUQ) + (size_t)l * 768 * 384, 384, (v % 6) * 64, (v / 6) * 64, 1, hl, tid); continue; }
    v -= 72;
    if (v < 64) { transpose_unit(p.mla_w_ukv + (size_t)l * 256 * 1024, 1024, (bf16_t*)(p.ws + OFF_WUKV) + (size_t)l * 1024 * 256, 256, (v % 4) * 64, (v / 4) * 64, 2, hl, tid); continue; }
    v -= 64;
    if (v < 256) { transpose_unit(p.w_out + (size_t)l * 1024 * 1024, 1024, (bf16_t*)(p.ws + OFF_WOUT) + (size_t)l * 1024 * 1024, 1024, (v % 16) * 64, (v / 16) * 64, 1, hl, tid); continue; }
    v -= 256;
    transpose_unit(p.conv_w_pw + (size_t)l * 256 * 256, 256, (bf16_t*)(p.ws + OFF_WPW) + (size_t)l * 256 * 256, 256, (v % 4) * 64, (v / 4) * 64, 1, hl, tid);
  }
}

DI void phase_prep(const Params& p, char* lds) {
  const int tx = otid();
  const int half = tx >> 8, tid = tx & 255;
  char* hl = lds + half * 65536;
  prep_weights(p, 0, blockIdx.x, gridDim.x, lds);
  for (int up = blockIdx.x; up < 96; up += gridDim.x) { const int v = up * 2 + half; mod_unit(p, v / 96, v % 96, hl, tid); }
  const size_t gt = (size_t)blockIdx.x * NTH + tx, gn = (size_t)gridDim.x * NTH;
  {
    bf16_t* wsb = (bf16_t*)(p.ws + OFF_WSB);
    for (size_t e = gt; e < (size_t)2 * 4 * 128 * 128; e += gn) {
      const int j = e & 127, i = (e >> 7) & 127;
      wsb[e] = f2bf(((j >> 6) <= (i >> 6)) ? p.gmlp_ws[e] : 0.f);
    }
  }
  {
    bf16_t* lats = (bf16_t*)(p.ws + OFF_LATS);
    for (size_t e = gt; e < (size_t)2 * 8 * PAST * 64; e += gn) {
      const size_t c4 = e & 63, row = (e >> 6) & (PAST - 1), lb = e >> 17;
      const f32x4 v = *(const f32x4*)(p.cache_latent + e * 4);
      u32x2 o; o.x = pk2(v[0], v[1]); o.y = pk2(v[2], v[3]);
      *(u32x2*)(lats + (lb * SKVP + row) * 256 + c4 * 4) = o;
    }
    bf16_t* krs = (bf16_t*)(p.ws + OFF_KRS);
    for (size_t e = gt; e < (size_t)2 * 8 * PAST * 8; e += gn) {
      const size_t c4 = e & 7, row = (e >> 3) & (PAST - 1), lb = e >> 14;
      const f32x4 v = *(const f32x4*)(p.cache_krope + e * 4);
      u32x2 o; o.x = pk2(v[0], v[1]); o.y = pk2(v[2], v[3]);
      *(u32x2*)(krs + (lb * SKVP + row) * 32 + c4 * 4) = o;
    }
    for (size_t e = gt; e < (size_t)16 * 48 * 64; e += gn) {
      const size_t c4 = e & 63, row = (e >> 6) % 48, lb = e / (48 * 64);
      *(u32x2*)(lats + (lb * SKVP + SKV + row) * 256 + c4 * 4) = (u32x2){0u, 0u};
    }
    for (size_t e = gt; e < (size_t)16 * 48 * 8; e += gn) {
      const size_t c4 = e & 7, row = (e >> 3) % 48, lb = e / (48 * 8);
      *(u32x2*)(krs + (lb * SKVP + SKV + row) * 32 + c4 * 4) = (u32x2){0u, 0u};
    }
  }
  {
    f32x2* cs = (f32x2*)(p.ws + OFF_CS);
    for (size_t e = gt; e < (size_t)16384 * 16; e += gn) {
      const int i = e & 15, pos = (int)(e >> 4);
      const double invrev = exp2(-(double)i * (13.287712379549449 / 16.0)) * 0.15915494309189535;
      double rev = (double)pos * invrev;
      rev -= rint(rev);
      const float fr = (float)rev;
      f32x2 o; o.x = __builtin_amdgcn_cosf(fr); o.y = __builtin_amdgcn_sinf(fr);
      cs[e] = o;
    }
  }
  {
    for (size_t e = gt; e < (size_t)16 * 14 * 256; e += gn) {
      const size_t c = e & 255, j = (e >> 8) % 14, lb = e / (14 * 256);
      p.out[O_SCONV + (lb * 30 + j) * 256 + c] = p.state_conv[(lb * 30 + 16 + j) * 256 + c];
    }
  }
}

DI void phase_ln(const Params& p, int mode) {
  const int tx = otid();
  const int lane = tx & 63;
  const int gw = blockIdx.x * 8 + (tx >> 6), nw = gridDim.x * 8;
  const float* r = p.out;
  bf16_t* hb = (bf16_t*)(p.ws + OFF_H);
  const float* mod = (const float*)(p.ws + OFF_MOD);
  auto rowsrc = [&](int t) { return mode == 0 ? (t < TP ? p.x_prompt + (size_t)t * 1024 : p.x_sample + (size_t)(t - TP) * 1024) : r + (size_t)t * 1024; };
  f32x4 vn[4];
  if (gw < T) {
#pragma unroll
    for (int i = 0; i < 4; ++i) vn[i] = *(const f32x4*)(rowsrc(gw) + lane * 4 + 256 * i);
  }
  for (int t = gw; t < T; t += nw) {
    f32x4 v[4];
#pragma unroll
    for (int i = 0; i < 4; ++i) v[i] = vn[i];
    if (t + nw < T) {
#pragma unroll
      for (int i = 0; i < 4; ++i) vn[i] = *(const f32x4*)(rowsrc(t + nw) + lane * 4 + 256 * i);
    }
    __builtin_amdgcn_sched_barrier(0);
    float s = 0.f;
#pragma unroll
    for (int i = 0; i < 4; ++i) s += (v[i][0] + v[i][1]) + (v[i][2] + v[i][3]);
    float mu = wsum(s) * (1.0f / 1024.0f);
    float q = 0.f;
#pragma unroll
    for (int i = 0; i < 4; ++i) { const f32x4 d = v[i] - mu; q += (d[0] * d[0] + d[1] * d[1]) + (d[2] * d[2] + d[3] * d[3]); }
    float rstd = rsqrtf(wsum(q) * (1.0f / 1024.0f) + LN_EPS);
    if (mode >= 1) {
      const int pl = mode - 1;
      s = 0.f;
#pragma unroll
      for (int i = 0; i < 4; ++i) {
        const f32x4 g = *(const f32x4*)(p.post_ln_g + pl * 1024 + lane * 4 + 256 * i), b = *(const f32x4*)(p.post_ln_b + pl * 1024 + lane * 4 + 256 * i);
        v[i] = (v[i] - mu) * rstd * g + b;
        if (mode == 2) __builtin_nontemporal_store(v[i], (f32x4*)(p.out + (size_t)t * 1024 + lane * 4 + 256 * i));
        s += (v[i][0] + v[i][1]) + (v[i][2] + v[i][3]);
      }
      if (mode == 2) continue;
      if (lane == 0) *(f32x2*)((float*)(p.ws + OFF_STATS) + (size_t)t * 2) = (f32x2){mu, rstd};
      mu = wsum(s) * (1.0f / 1024.0f);
      q = 0.f;
#pragma unroll
      for (int i = 0; i < 4; ++i) { const f32x4 d = v[i] - mu; q += (d[0] * d[0] + d[1] * d[1]) + (d[2] * d[2] + d[3] * d[3]); }
      rstd = rsqrtf(wsum(q) * (1.0f / 1024.0f) + LN_EPS);
    }
    const int l = mode == 0 ? 0 : 1;
    const float* mr = mod + ((size_t)l * 10 + mod_row(t)) * 3072;
#pragma unroll
    for (int i = 0; i < 4; ++i) {
      const f32x4 sh = *(const f32x4*)(mr + lane * 4 + 256 * i), sc = *(const f32x4*)(mr + 1024 + lane * 4 + 256 * i);
      const f32x4 o = (v[i] - mu) * rstd * (1.0f + sc) + sh;
      u32x2 w; w.x = pk2(o[0], o[1]); w.y = pk2(o[2], o[3]);
      *(u32x2*)(hb + (size_t)t * 1024 + lane * 4 + 256 * i) = w;
    }
  }
}

struct EpiZ {
  static constexpr bool ROPE = false, TAGGED = true;
  bf16_t* z;
  DI int tag(int nb) const { return nb < 512 ? 1 : (nb < 768 ? 2 : (nb < 1280 ? 0 : (nb < 1536 ? 2 : (nb < 2176 ? 0 : (nb < 2688 ? 2 : 0))))); }
  DI void quad(int m, int n, f32x4 v, int act) const {
    if (act == 1) { v[0] = geluf_(v[0]); v[1] = geluf_(v[1]); v[2] = geluf_(v[2]); v[3] = geluf_(v[3]); }
    else if (act == 2) { v[0] = siluf_(v[0]); v[1] = siluf_(v[1]); v[2] = siluf_(v[2]); v[3] = siluf_(v[3]); }
    u32x2 w; w.x = pk2(v[0], v[1]); w.y = pk2(v[2], v[3]);
    *(u32x2*)(z + (size_t)m * ZLD + n) = w;
  }
};
DI void phase_zgemm(const Params& p, int l, char* lds) {
  const bf16_t* hb = (const bf16_t*)(p.ws + OFF_H);
  const bf16_t* wt = (const bf16_t*)(p.ws + OFF_WIN) + (size_t)l * 2816 * 1024;
  EpiZ epi{(bf16_t*)(p.ws + OFF_Z)};
  g256::phase(hb, 1024, wt, 1024, 1024, TP, 2816, blockIdx.x, lds, epi);
  const int G = gridDim.x;
  int v0 = (int)blockIdx.x - (1408 % G); if (v0 < 0) v0 += G;
  for (int v = v0; v < 11; v += G) gemm_tile8(hb, 1024, wt, 1024, 1024, TP, v * 256, lds, epi);
  if (l == 0 && G == 256 && blockIdx.x >= 128) prep_weights(p, 1, blockIdx.x - 128, 128, lds);
  else if (l == 0 && G != 256) prep_weights(p, 1, blockIdx.x, G, lds);
}

DI void phase_rows(const Params& p, int l) {
  const int tx = otid();
  const int lane = tx & 63;
  const int gw = blockIdx.x * 8 + (tx >> 6), nw = gridDim.x * 8;
  bf16_t* z = (bf16_t*)(p.ws + OFF_Z);
  const f32x2* cs = (const f32x2*)(p.ws + OFF_CS);
  struct Raw { u32x2 v, ga, gg, kv; unsigned q0, q1, q2; bf16_t k1, k2; };
  auto load_row = [&](int t) {
    const bf16_t* zr = z + (size_t)t * ZLD;
    Raw r;
    r.v = *(const u32x2*)(zr + ZC_V + lane * 4);
    r.ga = *(const u32x2*)(zr + ZC_GLU + lane * 4); r.gg = *(const u32x2*)(zr + ZC_GLU + 256 + lane * 4);
    const unsigned* cp = (const unsigned*)(zr + ZC_CQ + lane * 6);
    r.q0 = cp[0]; r.q1 = cp[1]; r.q2 = cp[2];
    r.kv = *(const u32x2*)(zr + ZC_CKV + lane * 4);
    r.k1 = zr[ZC_KR + (lane & 15)]; r.k2 = zr[ZC_KR + 16 + (lane & 15)];
    return r;
  };
  Raw rn;
  if (gw < T) rn = load_row(gw);
  for (int t = gw; t < T; t += nw) {
    const Raw rw = rn;
    if (t + nw < T) rn = load_row(t + nw);
    __builtin_amdgcn_sched_barrier(0);
    bf16_t* zr = z + (size_t)t * ZLD;
    const bool samp = t >= TP;
    const int sb = (t - TP) >> 4, si = (t - TP) & 15;
    const int pb = t >> 14, pos = tok_pos(t);
    {
      const u32x2 raw = rw.v;
      f32x4 v = {bflo(raw.x), bfhi(raw.x), bflo(raw.y), bfhi(raw.y)};
      const float mu = wsum((v[0] + v[1]) + (v[2] + v[3])) * (1.0f / 256.0f);
      const f32x4 d = v - mu;
      const float rstd = rsqrtf(wsum((d[0] * d[0] + d[1] * d[1]) + (d[2] * d[2] + d[3] * d[3])) * (1.0f / 256.0f) + LN_EPS);
      const f32x4 g = *(const f32x4*)(p.gmlp_ln_g + l * 256 + lane * 4), b = *(const f32x4*)(p.gmlp_ln_b + l * 256 + lane * 4);
      v = d * rstd * g + b;
      u32x2 w; w.x = pk2(v[0], v[1]); w.y = pk2(v[2], v[3]);
      *(u32x2*)(zr + ZC_V + lane * 4) = w;
      if (samp) *(f32x4*)(p.out + O_SV + ((size_t)(l * 8 + sb) * 16 + si) * 256 + lane * 4) = v;
    }
    {
      const u32x2 ra = rw.ga, rg = rw.gg;
      f32x4 g;
      g[0] = bflo(ra.x) * sigmoidf_(bflo(rg.x)); g[1] = bfhi(ra.x) * sigmoidf_(bfhi(rg.x));
      g[2] = bflo(ra.y) * sigmoidf_(bflo(rg.y)); g[3] = bfhi(ra.y) * sigmoidf_(bfhi(rg.y));
      u32x2 w; w.x = pk2(g[0], g[1]); w.y = pk2(g[2], g[3]);
      *(u32x2*)(zr + ZC_GLU + lane * 4) = w;
      if (samp) *(f32x4*)(p.out + O_SCONV + ((size_t)(l * 8 + sb) * 30 + 14 + si) * 256 + lane * 4) = g;
      else if (pos >= SEQ - 30) *(f32x4*)(p.out + O_PCONV + ((size_t)(l * 2 + pb) * 30 + (pos - (SEQ - 30))) * 256 + lane * 4) = g;
    }
    {
      const unsigned r0 = rw.q0, r1 = rw.q1, r2 = rw.q2;
      float v[6] = {bflo(r0), bfhi(r0), bflo(r1), bfhi(r1), bflo(r2), bfhi(r2)};
      float q = 0.f;
#pragma unroll
      for (int i = 0; i < 6; ++i) q += v[i] * v[i];
      const float rr = rsqrtf(wsum(q) * (1.0f / 384.0f) + RMS_EPS);
      const float* gq = p.mla_q_norm + l * 384 + lane * 6;
#pragma unroll
      for (int i = 0; i < 6; ++i) v[i] = v[i] * rr * gq[i];
      unsigned* op = (unsigned*)(zr + ZC_CQ + lane * 6);
      op[0] = pk2(v[0], v[1]); op[1] = pk2(v[2], v[3]); op[2] = pk2(v[4], v[5]);
    }
    {
      const u32x2 raw = rw.kv;
      f32x4 v = {bflo(raw.x), bfhi(raw.x), bflo(raw.y), bfhi(raw.y)};
      const float rr = rsqrtf(wsum((v[0] * v[0] + v[1] * v[1]) + (v[2] * v[2] + v[3] * v[3])) * (1.0f / 256.0f) + RMS_EPS);
      const f32x4 g = *(const f32x4*)(p.mla_kv_norm + l * 256 + lane * 4);
      v = v * rr * g;
      u32x2 w; w.x = pk2(v[0], v[1]); w.y = pk2(v[2], v[3]);
      if (samp) {
        *(f32x4*)(p.out + O_SLAT + ((size_t)(l * 8 + sb) * 16 + si) * 256 + lane * 4) = v;
        *(u32x2*)((bf16_t*)(p.ws + OFF_LATS) + ((size_t)(l * 8 + sb) * SKVP + PAST + si) * 256 + lane * 4) = w;
      } else {
        __builtin_nontemporal_store(v, (f32x4*)(p.out + O_PLAT + ((size_t)(l * 2 + pb) * SEQ + pos) * 256 + lane * 4));
        *(u32x2*)(zr + ZC_CKV + lane * 4) = w;
      }
    }
    if (lane < 16) {
      const float x1 = bf2f(rw.k1), x2 = bf2f(rw.k2);
      const f32x2 c = cs[pos * 16 + lane];
      const float o1 = x1 * c.x - x2 * c.y, o2 = x1 * c.y + x2 * c.x;
      if (samp) {
        float* o = p.out + O_SKR + ((size_t)(l * 8 + sb) * 16 + si) * 32;
        o[lane] = o1; o[16 + lane] = o2;
        bf16_t* kb = (bf16_t*)(p.ws + OFF_KRS) + ((size_t)(l * 8 + sb) * SKVP + PAST + si) * 32;
        kb[lane] = f2bf(o1); kb[16 + lane] = f2bf(o2);
      } else {
        float* o = p.out + O_PKR + ((size_t)(l * 2 + pb) * SEQ + pos) * 32;
        o[lane] = o1; o[16 + lane] = o2;
        bf16_t* kb = (bf16_t*)(p.ws + OFF_KRP) + (size_t)t * 32;
        kb[lane] = f2bf(o1); kb[16 + lane] = f2bf(o2);
      }
    }
  }
}

struct EpiQ {
  static constexpr bool ROPE = false, TAGGED = false;
  bf16_t* q;
  DI void quad(int m, int n, f32x4 v) const {
    u32x2 w; w.x = pk2(v[0] * QSCALE, v[1] * QSCALE); w.y = pk2(v[2] * QSCALE, v[3] * QSCALE);
    *(u32x2*)(q + (size_t)m * 768 + n) = w;
  }
};
DI void rope_qfrag(bf16x8& f4, bf16x8& f5, const f32x2* cr) {
  u32x4 o4, o5;
#pragma unroll
  for (int j = 0; j < 8; j += 2) {
    const f32x2 ca = cr[j], cb = cr[j + 1];
    const float a1 = bf2f((bf16_t)f4[j]), a2 = bf2f((bf16_t)f5[j]), b1 = bf2f((bf16_t)f4[j + 1]), b2 = bf2f((bf16_t)f5[j + 1]);
    o4[j >> 1] = pk2(a1 * ca.x - a2 * ca.y, b1 * cb.x - b2 * cb.y);
    o5[j >> 1] = pk2(a1 * ca.y + a2 * ca.x, b1 * cb.y + b2 * cb.x);
  }
  f4 = __builtin_bit_cast(bf16x8, o4); f5 = __builtin_bit_cast(bf16x8, o5);
}
struct EpiStore {
  static constexpr bool ROPE = false, TAGGED = false;
  bf16_t* c; int ldc;
  DI void quad(int m, int n, f32x4 v) const {
    u32x2 w; w.x = pk2(v[0], v[1]); w.y = pk2(v[2], v[3]);
    *(u32x2*)(c + (size_t)m * ldc + n) = w;
  }
};
struct EpiKp {
  static constexpr bool ROPE = false, TAGGED = false;
  bf16_t* kp;
  DI void quad(int m, int n, f32x4 v) const {
    u32x2 w; w.x = pk2(v[0], v[1]); w.y = pk2(v[2], v[3]);
    *(u32x2*)(kp + (((size_t)(m >> 14) * 8 + (n >> 6)) * SEQ + (m & (SEQ - 1))) * 64 + (n & 63)) = w;
  }
};
struct EpiVt {
  static constexpr bool ROPE = false, TAGGED = false;
  bf16_t* vt;
  DI void quad(int m, int n, f32x4 v) const {
    const int b = n >> 14, pos = n & (SEQ - 1);
    u32x2 w; w.x = pk2(v[0], v[1]); w.y = pk2(v[2], v[3]);
    *(u32x2*)(vt + ((((size_t)(b * 8 + (m >> 6)) * 256 + (pos >> 6)) * 64 + (m & 63)) * 64 + swap23(pos & 63))) = w;
  }
};
struct EpiVts {
  static constexpr bool ROPE = false, TAGGED = false;
  bf16_t* vt;
  DI void quad(int m, int n, f32x4 v) const {
    u32x2 w; w.x = pk2(v[0], v[1]); w.y = pk2(v[2], v[3]);
    *(u32x2*)(vt + (size_t)m * SROWS + swap23(n)) = w;
  }
};

DI void gate_unit(const Params& p, int l, int ck, int hd, char* lds, int tid) {
  const int lane = tid & 63, w = tid >> 6;
  const bf16_t* z = (const bf16_t*)(p.ws + OFF_Z);
  const int t0 = ck * 128;
  constexpr int VROW = 272;
#pragma unroll
  for (int i = 0; i < 4; ++i) {
    const int c = tid + 256 * i, j = c >> 3, d0 = (c & 7) * 8;
    const u32x4 raw = *(const u32x4*)(z + (size_t)(t0 + j) * ZLD + ZC_V + hd * 64 + d0);
    bf16_t* dst = (bf16_t*)(lds + d0 * VROW) + j;
    dst[0 * (VROW / 2)] = (bf16_t)(raw.x & 0xffff); dst[1 * (VROW / 2)] = (bf16_t)(raw.x >> 16);
    dst[2 * (VROW / 2)] = (bf16_t)(raw.y & 0xffff); dst[3 * (VROW / 2)] = (bf16_t)(raw.y >> 16);
    dst[4 * (VROW / 2)] = (bf16_t)(raw.z & 0xffff); dst[5 * (VROW / 2)] = (bf16_t)(raw.z >> 16);
    dst[6 * (VROW / 2)] = (bf16_t)(raw.w & 0xffff); dst[7 * (VROW / 2)] = (bf16_t)(raw.w >> 16);
  }
  const bf16_t* wsb = (const bf16_t*)(p.ws + OFF_WSB) + ((size_t)(l * 4 + hd) * 128 + w * 32 + (lane & 31)) * 128 + (lane >> 5) * 8;
  bf16x8 afr[8];
#pragma unroll
  for (int s = 0; s < 8; ++s) afr[s] = *(const bf16x8*)(wsb + s * 16);
  __syncthreads();
  f32x16 a0 = zero16(), a1 = zero16();
  const char* vb = lds + (lane & 31) * VROW + (lane >> 5) * 16;
#pragma unroll
  for (int s = 0; s < 8; ++s) {
    if (s < 4 || w >= 2) {
      const bf16x8 b0 = *(const bf16x8*)(vb + s * 32), b1 = *(const bf16x8*)(vb + 32 * VROW + s * 32);
      a0 = mfma32(b0, afr[s], a0); a1 = mfma32(b1, afr[s], a1);
    }
  }
  const int i = w * 32 + (lane & 31), t = t0 + i, hh = lane >> 5;
  const float bs = p.gmlp_bs[(l * 4 + hd) * 128 + i];
  const bf16_t* zr = z + (size_t)t * ZLD;
  bf16_t* ym = (bf16_t*)(p.ws + OFF_YMIX) + (size_t)t * 1024;
#pragma unroll
  for (int jb = 0; jb < 2; ++jb)
#pragma unroll
    for (int g = 0; g < 4; ++g) {
      const int d = hd * 64 + jb * 32 + 8 * g + 4 * hh;
      const u32x2 u = *(const u32x2*)(zr + ZC_U + d), ga = *(const u32x2*)(zr + ZC_GA + d);
      const f32x16& a = jb ? a1 : a0;
      u32x2 o;
      o.x = pk2(bflo(u.x) * (a[4 * g] + bs) * bflo(ga.x), bfhi(u.x) * (a[4 * g + 1] + bs) * bfhi(ga.x));
      o.y = pk2(bflo(u.y) * (a[4 * g + 2] + bs) * bflo(ga.y), bfhi(u.y) * (a[4 * g + 3] + bs) * bfhi(ga.y));
      *(u32x2*)(ym + d) = o;
    }
  __syncthreads();
}

DI void sgate_unit(const Params& p, int l, int b, int c) {
  const int hd = c >> 6;
  const bf16_t* z = (const bf16_t*)(p.ws + OFF_Z) + (size_t)(TP + b * 16) * ZLD;
  float v[16];
#pragma unroll
  for (int j = 0; j < 16; ++j) v[j] = bf2f(z[(size_t)j * ZLD + ZC_V + c]);
  const float* ws = p.gmlp_ws + (size_t)(l * 4 + hd) * 128 * 128;
  bf16_t* ym = (bf16_t*)(p.ws + OFF_YMIX) + (size_t)(TP + b * 16) * 1024;
#pragma unroll 1
  for (int i = 0; i < 16; ++i) {
    float s = p.gmlp_bs[(l * 4 + hd) * 128 + i];
#pragma unroll
    for (int j = 0; j < 16; ++j) s += ws[i * 128 + j] * v[j];
    const float u = bf2f(z[(size_t)i * ZLD + ZC_U + c]), ga = bf2f(z[(size_t)i * ZLD + ZC_GA + c]);
    ym[(size_t)i * 1024 + c] = f2bf(u * s * ga);
  }
}

typedef __bf16 bf2v __attribute__((ext_vector_type(2)));
DI float dot2bf(unsigned a, unsigned b, float c) { return __builtin_amdgcn_fdot2_f32_bf16(__builtin_bit_cast(bf2v, a), __builtin_bit_cast(bf2v, b), c, false); }
DI void conv_unit(const Params& p, int l, int cu, char* lds, int tid) {
  const int lane = tid & 63, w = tid >> 6;
  int oz = 0; asm volatile("" : "+s"(oz));
  const bf16_t* z = (const bf16_t*)(p.ws + OFF_Z);
  const bool samp = cu >= 1024;
  const int ntok = samp ? 16 : 32;
  const int t0 = samp ? TP + (cu - 1024) * 16 : cu * 32;
  const int pos0 = samp ? 0 : (t0 & (SEQ - 1));
  constexpr int CROW = 136;
  char* xt = lds;
  float* yb = (float*)lds;
  char* ab = lds + 36864;
  const int nrows = ntok + 30;
  for (int c = tid; c < nrows * 32; c += 256) {
    const int j = c >> 5, ch = (c & 31) * 8;
    u32x4 v = {0u, 0u, 0u, 0u};
    if (samp) {
      if (j < 30) {
        const float* s = p.state_conv + ((size_t)(l * 8 + (cu - 1024)) * 30 + j) * 256 + ch;
        const f32x4 a = *(const f32x4*)s, b = *(const f32x4*)(s + 4);
        v.x = pk2(a[0], a[1]); v.y = pk2(a[2], a[3]); v.z = pk2(b[0], b[1]); v.w = pk2(b[2], b[3]);
      } else v = *(const u32x4*)(z + (size_t)(t0 + j - 30) * ZLD + ZC_GLU + ch);
    } else {
      if (pos0 + j - 30 >= 0) v = *(const u32x4*)(z + (size_t)(t0 + j - 30) * ZLD + ZC_GLU + ch);
    }
    bf16_t* dst = (bf16_t*)(xt + ch * CROW) + j;
    dst[0 * (CROW / 2)] = (bf16_t)(v.x & 0xffff); dst[1 * (CROW / 2)] = (bf16_t)(v.x >> 16);
    dst[2 * (CROW / 2)] = (bf16_t)(v.y & 0xffff); dst[3 * (CROW / 2)] = (bf16_t)(v.y >> 16);
    dst[4 * (CROW / 2)] = (bf16_t)(v.z & 0xffff); dst[5 * (CROW / 2)] = (bf16_t)(v.z >> 16);
    dst[6 * (CROW / 2)] = (bf16_t)(v.w & 0xffff); dst[7 * (CROW / 2)] = (bf16_t)(v.w >> 16);
  }
  unsigned WE[16], WO[16];
  {
    const float* wk = p.conv_dw_k + (size_t)l * 31 * 256 + tid + oz;
    float prev = 0.f;
#pragma unroll
    for (int j = 0; j < 16; ++j) {
      const float a = wk[(2 * j) * 256], b = (2 * j + 1 < 31) ? wk[(2 * j + 1) * 256] : 0.f;
      WE[j] = pk2(a, b); WO[j] = pk2(prev, a); prev = b;
    }
  }
  const float bias = p.conv_dw_b[l * 256 + tid + oz];
  __syncthreads();
  unsigned xr[32];
#pragma unroll
  for (int i = 0; i < 16; ++i) { const u32x2 v = *(const u32x2*)(xt + tid * CROW + i * 8); xr[2 * i] = v.x; xr[2 * i + 1] = v.y; }
  __syncthreads();
#pragma unroll
  for (int t = 0; t < 32; ++t) {
    if (t < ntok) {
      float acc = bias;
#pragma unroll
      for (int j = 0; j < 16; ++j) acc = dot2bf(xr[(t >> 1) + j], (t & 1) ? WO[j] : WE[j], acc);
      yb[t * 256 + tid] = acc;
    }
  }
  __builtin_amdgcn_sched_barrier(0);
  bf16x8 bfr[16][2];
  {
    const bf16_t* wp = (const bf16_t*)(p.ws + OFF_WPW) + (size_t)l * 256 * 256 + (size_t)(w * 64 + (lane & 31)) * 256 + (lane >> 5) * 8 + oz;
#pragma unroll
    for (int s = 0; s < 16; ++s) { bfr[s][0] = *(const bf16x8*)(wp + s * 16); bfr[s][1] = *(const bf16x8*)(wp + 32 * 256 + s * 16); }
  }
  __syncthreads();
  constexpr int AROW = 528;
  {
    const f32x4 g = *(const f32x4*)(p.conv_ln_g + l * 256 + lane * 4 + oz), b = *(const f32x4*)(p.conv_ln_b + l * 256 + lane * 4 + oz);
    for (int tt = w; tt < 32; tt += 4) {
      u32x2 o = {0u, 0u};
      if (tt < ntok) {
        const f32x4 v = *(const f32x4*)(yb + tt * 256 + lane * 4);
        const float mu = wsum((v[0] + v[1]) + (v[2] + v[3])) * (1.0f / 256.0f);
        const f32x4 d = v - mu;
        const float rstd = rsqrtf(wsum((d[0] * d[0] + d[1] * d[1]) + (d[2] * d[2] + d[3] * d[3])) * (1.0f / 256.0f) + LN_EPS);
        const f32x4 y = d * rstd * g + b;
        o.x = pk2(siluf_(y[0]), siluf_(y[1])); o.y = pk2(siluf_(y[2]), siluf_(y[3]));
      }
      *(u32x2*)(ab + tt * AROW + lane * 8) = o;
    }
  }
  __syncthreads();
  {
    const char* abp = ab + (lane & 31) * AROW + (lane >> 5) * 16;
    f32x16 a0 = zero16(), a1 = zero16();
#pragma unroll
    for (int s = 0; s < 16; ++s) {
      const bf16x8 af = *(const bf16x8*)(abp + s * 32);
      a0 = mfma32(bfr[s][0], af, a0); a1 = mfma32(bfr[s][1], af, a1);
    }
    const int i = lane & 31, hh = lane >> 5;
    if (i < ntok) {
      const int t = t0 + i;
      const bf16_t* zr = z + (size_t)t * ZLD + ZC_GB;
      bf16_t* ym = (bf16_t*)(p.ws + OFF_YMIX) + (size_t)t * 1024 + 256;
#pragma unroll
      for (int jb = 0; jb < 2; ++jb)
#pragma unroll
        for (int g = 0; g < 4; ++g) {
          const int n = w * 64 + jb * 32 + 8 * g + 4 * hh;
          const f32x4 bp = *(const f32x4*)(p.conv_b_pw + l * 256 + n + oz);
          const u32x2 gb = *(const u32x2*)(zr + n);
          const f32x16& a = jb ? a1 : a0;
          u32x2 o;
          o.x = pk2((a[4 * g] + bp[0]) * bflo(gb.x), (a[4 * g + 1] + bp[1]) * bfhi(gb.x));
          o.y = pk2((a[4 * g + 2] + bp[2]) * bflo(gb.y), (a[4 * g + 3] + bp[3]) * bfhi(gb.y));
          *(u32x2*)(ym + n) = o;
        }
    }
  }
  __syncthreads();
}

DI void phase_mix(const Params& p, int l, char* lds) {
  const int tx = otid();
  const bf16_t* z = (const bf16_t*)(p.ws + OFF_Z);
  const bf16_t* wuq = (const bf16_t*)(p.ws + OFF_WUQ) + (size_t)l * 768 * 384;
  const bf16_t* wukv = (const bf16_t*)(p.ws + OFF_WUKV) + (size_t)l * 1024 * 256;
  const bf16_t* lats = (const bf16_t*)(p.ws + OFF_LATS) + (size_t)l * SROWS * 256;
  const int G = gridDim.x, c = blockIdx.x;
  auto first = [&](int b) { const int r = c - (b % G); return r < 0 ? r + G : r; };
  int base = 0;
  {
    EpiQ e{(bf16_t*)(p.ws + OFF_H)};
    g256::phase(z + ZC_CQ, ZLD, wuq, 384, 384, TP, 768, first(base), lds, e);
    base += 384;
    EpiKp ek{(bf16_t*)(p.ws + OFF_KP)};
    g256::phase(z + ZC_CKV, ZLD, wukv, 256, 256, TP, 512, first(base), lds, ek);
    base += 256;
    EpiVt ev{(bf16_t*)(p.ws + OFF_VTP)};
    g256::phase(wukv + 512 * 256, 256, z + ZC_CKV, ZLD, 256, 512, TP, first(base), lds, ev);
    base += 256;
    EpiStore eks{(bf16_t*)(p.ws + OFF_KS), 512};
    g256::phase(lats, 256, wukv, 256, 256, SROWS, 512, first(base), lds, eks);
    base += 136;
    EpiVts evs{(bf16_t*)(p.ws + OFF_VTS)};
    g256::phase(wukv + 512 * 256, 256, lats, 256, 256, 512, SROWS, first(base), lds, evs);
    base += 132;
    for (int v = first(base); v < 3; v += G) gemm_tile8(z + ZC_CQ, ZLD, wuq, 384, 384, TP, v * 256, lds, e);
    base += 3;
  }
  const int half = tx >> 8, tid = tx & 255;
  char* hl = lds + half * 65536;
  for (int v = first(base); v < 516; v += G) conv_unit(p, l, v * 2 + half, hl, tid);
  base += 516;
  for (int v = first(base); v < 512; v += G) { const int u = v * 2 + half; gate_unit(p, l, u >> 2, u & 3, hl, tid); }
  base += 512;
  for (int v = first(base); v < 4; v += G) sgate_unit(p, l, v * 2 + half, tid);
}

constexpr int KROW = 208, VROWB = 144, KT_BYTES = 64 * KROW, ATT_STAGE = KT_BYTES + 64 * VROWB;

constexpr float ATT_RAISE = 24.0f;
DI void attn_tile_math(f32x16& s0, f32x16& s1, float& m, float& lsum, f32x16& o0, f32x16& o1, const bf16x8 (&vf)[2][2][2]) {
  if (__builtin_amdgcn_ballot_w64(m != 0.f) != 0) {
#pragma unroll
    for (int r = 0; r < 16; ++r) { s0[r] -= m; s1[r] -= m; }
  }
  int mi = max(__builtin_bit_cast(int, s0[0]), __builtin_bit_cast(int, s1[0]));
#pragma unroll
  for (int r = 1; r < 16; ++r) mi = max(mi, max(__builtin_bit_cast(int, s0[r]), __builtin_bit_cast(int, s1[r])));
  mi = max(mi, __shfl_xor(mi, 32));
  const bool up = mi > __builtin_bit_cast(int, ATT_RAISE);
  if (__builtin_amdgcn_ballot_w64(up) != 0) {
    const float delta = up ? __builtin_bit_cast(float, mi) : 0.f;
    const float alpha = __builtin_amdgcn_exp2f(-delta);
    m += delta; lsum *= alpha; o0 *= alpha; o1 *= alpha;
#pragma unroll
    for (int r = 0; r < 16; ++r) { s0[r] -= delta; s1[r] -= delta; }
  }
  float rs = 0.f;
#pragma unroll
  for (int r = 0; r < 16; ++r) { s0[r] = __builtin_amdgcn_exp2f(s0[r]); s1[r] = __builtin_amdgcn_exp2f(s1[r]); rs += s0[r] + s1[r]; }
  lsum += rs;
#pragma unroll
  for (int kb = 0; kb < 2; ++kb)
#pragma unroll
    for (int ks = 0; ks < 2; ++ks) {
      const f32x16& sv = kb ? s1 : s0;
      u32x4 pw;
      pw.x = pk2(sv[8 * ks + 0], sv[8 * ks + 1]); pw.y = pk2(sv[8 * ks + 2], sv[8 * ks + 3]);
      pw.z = pk2(sv[8 * ks + 4], sv[8 * ks + 5]); pw.w = pk2(sv[8 * ks + 6], sv[8 * ks + 7]);
      const bf16x8 pf = __builtin_bit_cast(bf16x8, pw);
      o0 = mfma32(vf[0][kb][ks], pf, o0); o1 = mfma32(vf[1][kb][ks], pf, o1);
    }
}
DI f32x16 splat16(float v) { f32x16 z; for (int i = 0; i < 16; ++i) z[i] = v; return z; }

DI void attn_unit(const Params& p, int b, int h, int qt, char* lds) {
  const int tx = otid();
  const int tid = tx, lane = tid & 63, w = __builtin_amdgcn_readfirstlane(tid >> 6);
  const bf16_t* z = (const bf16_t*)(p.ws + OFF_Z);
  const bf16_t* Q = (const bf16_t*)(p.ws + OFF_H);
  const bf16_t* Kp = (const bf16_t*)(p.ws + OFF_KP);
  const bf16_t* Vt = (const bf16_t*)(p.ws + OFF_VTP);
  const int nT = 2 * qt + 2, my_nkt = 4 * qt + 1 + (w >> 1);
  const size_t trow = (size_t)b * SEQ + qt * 256 + w * 32 + (lane & 31);
  bf16x8 qf[6];
#pragma unroll
  for (int s = 0; s < 6; ++s) qf[s] = *(const bf16x8*)(Q + trow * 768 + h * 96 + s * 16 + (lane >> 5) * 8);
  rope_qfrag(qf[4], qf[5], (const f32x2*)(p.ws + OFF_CS) + (size_t)(qt * 256 + w * 32 + (lane & 31)) * 16 + (lane >> 5) * 8);
  const bf16_t* kg0 = Kp + ((size_t)(b * 8 + h) * SEQ) * 64 + tid * 8;
  const bf16_t* kg1 = (const bf16_t*)(p.ws + OFF_KRP) + ((size_t)b * SEQ) * 32 + (tid & 255) * 8;
  constexpr size_t kst0 = 64 * 64, kst1 = 64 * 32, vst = 4096;
  const int klo0 = (tid >> 3) * KROW + (tid & 7) * 16, klo1 = ((tid & 255) >> 2) * KROW + (8 + (tid & 3)) * 16;
  const bool two = tid < 256;
  const bf16_t* vg = Vt + ((size_t)(b * 8 + h) * 256) * 4096 + tid * 8;
  const int vlo = KT_BYTES + (tid >> 3) * VROWB + (tid & 7) * 16;
  u32x4 rk0[2], rk1[2], rv[2];
  rk1[0] = rk1[1] = (u32x4){0u, 0u, 0u, 0u};
#define ATT_GLOAD(T) do { _Pragma("unroll") for (int sb = 0; sb < 2; ++sb) { const size_t kt_ = (size_t)(2 * (T) + sb); \
    rk0[sb] = *(const u32x4*)(kg0 + kt_ * kst0); if (two) rk1[sb] = *(const u32x4*)(kg1 + kt_ * kst1); rv[sb] = *(const u32x4*)(vg + kt_ * vst); } } while (0)
#define ATT_LSTORE(slot) do { _Pragma("unroll") for (int sb = 0; sb < 2; ++sb) { char* st_ = lds + ((slot) * 2 + sb) * ATT_STAGE; \
    *(u32x4*)(st_ + klo0) = rk0[sb]; if (two) *(u32x4*)(st_ + klo1) = rk1[sb]; *(u32x4*)(st_ + vlo) = rv[sb]; } } while (0)
  ATT_GLOAD(0);
  ATT_LSTORE(0);
  __syncthreads();
  if (w < 4) __builtin_amdgcn_s_setprio(2); else __builtin_amdgcn_s_setprio(0);
  f32x16 o0 = zero16(), o1 = zero16();
  float m = 0.f, lsum = 0.f;
  const int kfo = (lane & 31) * KROW + (lane >> 5) * 16;
  const int vfo = KT_BYTES + (lane & 31) * VROWB + (lane >> 5) * 16;
  for (int T = 0; T < nT; ++T) {
    if (T + 1 < nT) ATT_GLOAD(T + 1);
    __builtin_amdgcn_sched_barrier(0);
    if (2 * T < my_nkt) {
      const char* sta = lds + ((T & 1) * 2) * ATT_STAGE;
      const char* stb = sta + ATT_STAGE;
      const bool actb = 2 * T + 1 < my_nkt;
      bf16x8 kf0[6], kf1[6], vf[2][2][2];
#define LDKF(stp) do { _Pragma("unroll") for (int s = 0; s < 6; ++s) { kf0[s] = *(const bf16x8*)((stp) + kfo + s * 32); kf1[s] = *(const bf16x8*)((stp) + kfo + 32 * KROW + s * 32); } } while (0)
#define LDVF(stp) do { _Pragma("unroll") for (int db = 0; db < 2; ++db) _Pragma("unroll") for (int kb = 0; kb < 2; ++kb) _Pragma("unroll") for (int ks = 0; ks < 2; ++ks) \
    vf[db][kb][ks] = *(const bf16x8*)((stp) + vfo + db * 32 * VROWB + (32 * kb + 16 * ks) * 2); } while (0)
      LDKF(sta);
      f32x16 s0 = zero16(), s1 = zero16();
#pragma unroll
      for (int s = 0; s < 6; ++s) { s0 = mfma32(kf0[s], qf[s], s0); s1 = mfma32(kf1[s], qf[s], s1); }
      __builtin_amdgcn_sched_barrier(0);
      LDVF(sta);
      if (actb) { _Pragma("unroll") for (int s = 0; s < 6; ++s) kf0[s] = *(const bf16x8*)(stb + kfo + s * 32); }
      __builtin_amdgcn_sched_barrier(0);
      attn_tile_math(s0, s1, m, lsum, o0, o1, vf);
      if (actb) {
#pragma unroll
        for (int s = 0; s < 6; ++s) kf1[s] = *(const bf16x8*)(stb + kfo + 32 * KROW + s * 32);
        s0 = zero16(); s1 = zero16();
#pragma unroll
        for (int s = 0; s < 6; ++s) s0 = mfma32(kf0[s], qf[s], s0);
#pragma unroll
        for (int s = 0; s < 6; ++s) s1 = mfma32(kf1[s], qf[s], s1);
        LDVF(stb);
        attn_tile_math(s0, s1, m, lsum, o0, o1, vf);
      }
#undef LDKF
#undef LDVF
    }
    __builtin_amdgcn_sched_barrier(0);
    if (T + 1 < nT) ATT_LSTORE((T + 1) & 1);
    __syncthreads();
  }
#undef ATT_GLOAD
#undef ATT_LSTORE
  __builtin_amdgcn_s_setprio(0);
  lsum += __shfl_xor(lsum, 32);
  const float inv = 1.0f / lsum;
  const int hh = lane >> 5;
  const bf16_t* gc = z + trow * ZLD + ZC_GC + h * 64;
  bf16_t* ym = (bf16_t*)(p.ws + OFF_YMIX) + trow * 1024 + 512 + h * 64;
#pragma unroll
  for (int db = 0; db < 2; ++db)
#pragma unroll
    for (int g = 0; g < 4; ++g) {
      const int d = db * 32 + 8 * g + 4 * hh;
      const u32x2 gv = *(const u32x2*)(gc + d);
      const f32x16& o = db ? o1 : o0;
      u32x2 wv;
      wv.x = pk2(o[4 * g] * inv * bflo(gv.x), o[4 * g + 1] * inv * bfhi(gv.x));
      wv.y = pk2(o[4 * g + 2] * inv * bflo(gv.y), o[4 * g + 3] * inv * bfhi(gv.y));
      *(u32x2*)(ym + d) = wv;
    }
}

DI void sattn_unit(const Params& p, int l, int b, int h, char* lds) {
  const int tx = otid();
  const int tid = tx, lane = tid & 63, w = tid >> 6, hh = lane >> 5;
  const bf16_t* z = (const bf16_t*)(p.ws + OFF_Z);
  const bf16_t* Q = (const bf16_t*)(p.ws + OFF_H);
  const bf16_t* Ks = (const bf16_t*)(p.ws + OFF_KS) + (size_t)b * SKVP * 512 + h * 64;
  const bf16_t* krs = (const bf16_t*)(p.ws + OFF_KRS) + (size_t)(l * 8 + b) * SKVP * 32;
  const bf16_t* Vts = (const bf16_t*)(p.ws + OFF_VTS) + (size_t)(h * 64) * SROWS + (size_t)b * SKVP;
  const size_t trow = (size_t)TP + b * 16 + (lane & 15);
  bf16x8 qf[6];
#pragma unroll
  for (int s = 0; s < 6; ++s) qf[s] = *(const bf16x8*)(Q + trow * 768 + h * 96 + s * 16 + hh * 8);
  rope_qfrag(qf[4], qf[5], (const f32x2*)(p.ws + OFF_CS) + (size_t)(PAST + (lane & 15)) * 16 + hh * 8);
  f32x16 o0 = zero16(), o1 = zero16();
  float m = 0.f, lsum = 0.f;
  bf16x8 kf0[6], kf1[6];
#define SK_LOAD(kt_) do { const size_t key_ = (size_t)(kt_) * 64 + (lane & 31); _Pragma("unroll") for (int s = 0; s < 6; ++s) { \
    kf0[s] = s < 4 ? *(const bf16x8*)(Ks + key_ * 512 + s * 16 + hh * 8) : *(const bf16x8*)(krs + key_ * 32 + (s - 4) * 16 + hh * 8); \
    kf1[s] = s < 4 ? *(const bf16x8*)(Ks + (key_ + 32) * 512 + s * 16 + hh * 8) : *(const bf16x8*)(krs + (key_ + 32) * 32 + (s - 4) * 16 + hh * 8); } } while (0)
  SK_LOAD(w);
  for (int kt = w; kt < 33; kt += 8) {
    bf16x8 vf[2][2][2];
#pragma unroll
    for (int db = 0; db < 2; ++db)
#pragma unroll
      for (int kb = 0; kb < 2; ++kb)
#pragma unroll
        for (int ks = 0; ks < 2; ++ks) vf[db][kb][ks] = *(const bf16x8*)(Vts + (size_t)(db * 32 + (lane & 31)) * SROWS + kt * 64 + 32 * kb + 16 * ks + 8 * hh);
    f32x16 s0 = zero16(), s1 = zero16();
#pragma unroll
    for (int s = 0; s < 6; ++s) { s0 = mfma32(kf0[s], qf[s], s0); s1 = mfma32(kf1[s], qf[s], s1); }
    __builtin_amdgcn_sched_barrier(0);
    if (kt + 8 < 33) SK_LOAD(kt + 8);
    __builtin_amdgcn_sched_barrier(0);
    if (kt == 32) {
#pragma unroll
      for (int r = 8; r < 16; ++r) s0[r] = -1e30f;
      s1 = splat16(-1e30f);
    }
    attn_tile_math(s0, s1, m, lsum, o0, o1, vf);
  }
#undef SK_LOAD
  lsum += __shfl_xor(lsum, 32);
  float* Ow = (float*)lds;
  float* mw = Ow + 8 * 64 * 32;
  float* lw = mw + 8 * 32;
#pragma unroll
  for (int db = 0; db < 2; ++db)
#pragma unroll
    for (int r = 0; r < 16; ++r) {
      const int d = db * 32 + (r & 3) + 8 * (r >> 2) + 4 * hh;
      Ow[(w * 64 + d) * 32 + (lane & 31)] = db ? o1[r] : o0[r];
    }
  if (hh == 0) { mw[w * 32 + lane] = m; lw[w * 32 + lane] = lsum; }
  __syncthreads();
#pragma unroll
  for (int j = 0; j < 2; ++j) {
    const int idx = tid + 512 * j, q = idx & 15, d = idx >> 4;
    float M = mw[q];
#pragma unroll
    for (int ww = 1; ww < 8; ++ww) M = fmaxf(M, mw[ww * 32 + q]);
    float L = 0.f, O = 0.f;
#pragma unroll
    for (int ww = 0; ww < 8; ++ww) { const float sc = __builtin_amdgcn_exp2f(mw[ww * 32 + q] - M); L += lw[ww * 32 + q] * sc; O += Ow[(ww * 64 + d) * 32 + q] * sc; }
    const int t = TP + b * 16 + q;
    const float gcv = bf2f(z[(size_t)t * ZLD + ZC_GC + h * 64 + d]);
    ((bf16_t*)(p.ws + OFF_YMIX))[(size_t)t * 1024 + 512 + h * 64 + d] = f2bf(O / L * gcv);
  }
  __syncthreads();
}

DI void phase_attn(const Params& p, int l, char* lds) {
  const int G = gridDim.x;
  for (int u = blockIdx.x; u < 64; u += G) sattn_unit(p, l, u >> 3, u & 7, lds);
  int v0 = (int)blockIdx.x - (64 % G); if (v0 < 0) v0 += G;
  for (int pr = v0; pr < 512; pr += G) {
    const int bh = (pr & 7) + 8 * ((pr >> 8) & 1), q = (pr >> 3) & 31;
    attn_unit(p, bh >> 3, bh & 7, 63 - q, lds);
    attn_unit(p, bh >> 3, bh & 7, q, lds);
  }
}

template <int L>
struct EpiOut {
  static constexpr bool ROPE = false, TAGGED = false;
  const float* xa; const float* xb; float* r; const float* mod; const float* stats; const float* g0; const float* b0;
  DI void quad(int m, int n, f32x4 v) const {
    const float* gate = mod + (size_t)mod_row(m) * 3072 + 2048;
    const f32x4 gv = *(const f32x4*)(gate + n);
    f32x4 xv;
    if (L == 0) xv = *(const f32x4*)((m < TP ? xa + (size_t)m * 1024 : xb + (size_t)(m - TP) * 1024) + n);
    else {
      const f32x2 st = *(const f32x2*)(stats + (size_t)m * 2);
      xv = (*(const f32x4*)(r + (size_t)m * 1024 + n) - st.x) * st.y * *(const f32x4*)(g0 + n) + *(const f32x4*)(b0 + n);
    }
    f32x4 o;
    o[0] = ALPHA * xv[0] + gv[0] * v[0]; o[1] = ALPHA * xv[1] + gv[1] * v[1];
    o[2] = ALPHA * xv[2] + gv[2] * v[2]; o[3] = ALPHA * xv[3] + gv[3] * v[3];
    *(f32x4*)(r + (size_t)m * 1024 + n) = o;
  }
};
template <int L>
DI void phase_out(const Params& p, char* lds) {
  EpiOut<L> e;
  e.xa = p.x_prompt; e.xb = p.x_sample;
  e.r = p.out;
  e.mod = (const float*)(p.ws + OFF_MOD) + (size_t)L * 10 * 3072;
  e.stats = (const float*)(p.ws + OFF_STATS); e.g0 = p.post_ln_g; e.b0 = p.post_ln_b;
  const bf16_t* ym = (const bf16_t*)(p.ws + OFF_YMIX);
  const bf16_t* wt = (const bf16_t*)(p.ws + OFF_WOUT) + (size_t)L * 1024 * 1024;
  g256::phase(ym, 1024, wt, 1024, 1024, TP, 1024, blockIdx.x, lds, e);
  for (int v = blockIdx.x; v < 4; v += gridDim.x) gemm_tile8(ym, 1024, wt, 1024, 1024, TP, v * 256, lds, e);
}

#define XB_TMO      128
#define XB_XCNT(j)  (256  + 64 * (j))
#define XB_XSUB(j)  (1280 + 64 * (j))
#define XB_XGEN(j)  (2304 + 64 * (j))
#define XB_TOP      3328
#define XB_TOPGEN   3392
#define XCD_BAR_WORDS 3456
#define XB_SPIN_CAP (1u << 18)
#define XLAS __attribute__((address_space(3)))
DI unsigned xb_ld(unsigned* p) { return __hip_atomic_load(p, __ATOMIC_RELAXED, __HIP_MEMORY_SCOPE_AGENT); }
DI unsigned xb_add(unsigned* p, unsigned v) { return __hip_atomic_fetch_add(p, v, __ATOMIC_RELAXED, __HIP_MEMORY_SCOPE_AGENT); }
DI unsigned xb_xcc_id() { return (unsigned)__builtin_amdgcn_s_getreg((3 << 11) | 20) & 0xFu; }
#define XB_SPIN(cond, bar) do { unsigned _sp = 0; while (cond) { __builtin_amdgcn_s_sleep(1); \
    if ((++_sp & 255u) == 0u) { if (xb_ld(&(bar)[XB_TMO])) break; if (_sp > XB_SPIN_CAP) { atomicAdd(&(bar)[XB_TMO], 1u); break; } } } } while (0)
struct XcdBarrier { unsigned* bar; unsigned x; volatile XLAS unsigned* st; };
DI XcdBarrier xcd_barrier_post(unsigned* bar, volatile XLAS unsigned* st) {
  XcdBarrier b; b.bar = bar; b.x = xb_xcc_id(); b.st = st;
  if (threadIdx.x == 0) (void)xb_add(&bar[XB_XCNT(b.x)], 1u);
  return b;
}
DI void xcd_barrier_complete(unsigned* bar, unsigned x, unsigned& nloc, unsigned& nx) {
  const unsigned G = gridDim.x * gridDim.y * gridDim.z;
  unsigned sum, cnt, mine, sp = 0u;
  for (;;) {
    sum = 0u; cnt = 0u; mine = 0u;
#pragma unroll
    for (unsigned j = 0; j < 16; ++j) { const unsigned c = xb_ld(&bar[XB_XCNT(j)]); sum += c; cnt += (c > 0u) ? 1u : 0u; mine = (j == x) ? c : mine; }
    if (sum == G) break;
    __builtin_amdgcn_s_sleep(1);
    if ((++sp & 255u) == 0u) { if (xb_ld(&bar[XB_TMO])) break; if (sp > XB_SPIN_CAP) { atomicAdd(&bar[XB_TMO], 1u); break; } }
  }
  nloc = mine > 0u ? mine : 1u; nx = cnt > 0u ? cnt : 1u;
}
DI void xcd_barrier(const XcdBarrier& b) {
  asm volatile("s_waitcnt vmcnt(0)" ::: "memory");
  __syncthreads();
  if (threadIdx.x == 0) {
    unsigned* bar = b.bar;
    __builtin_amdgcn_s_waitcnt(0);
    unsigned nloc = b.st[0], nx = b.st[1];
    if (nloc == 0u) { xcd_barrier_complete(bar, b.x, nloc, nx); b.st[0] = nloc; b.st[1] = nx; }
    const unsigned old = xb_add(&bar[XB_XSUB(b.x)], 1u);
    const unsigned gen = old / nloc;
    if (old + 1u == (gen + 1u) * nloc) {
      __builtin_amdgcn_fence(__ATOMIC_RELEASE, "agent");
      asm volatile("s_waitcnt vmcnt(0)" ::: "memory");
      const unsigned og = xb_add(&bar[XB_TOP], 1u);
      const unsigned tg = og / nx;
      if (og + 1u == (tg + 1u) * nx) xb_add(&bar[XB_TOPGEN], 1u);
      else XB_SPIN(xb_ld(&bar[XB_TOPGEN]) == tg, bar);
      __builtin_amdgcn_fence(__ATOMIC_ACQUIRE, "agent");
      xb_add(&bar[XB_XGEN(b.x)], 1u);
      asm volatile("s_waitcnt vmcnt(0)" ::: "memory");
    } else {
      XB_SPIN(xb_ld(&bar[XB_XGEN(b.x)]) == gen, bar);
      __builtin_amdgcn_fence(__ATOMIC_ACQUIRE, "agent");
      asm volatile("s_waitcnt vmcnt(0)" ::: "memory");
    }
  }
  __syncthreads();
}

template <int L>
DI void layer_phases(const Params& p, char* lds, const XcdBarrier& xb) {
  phase_ln(p, L);
  xcd_barrier(xb);
  phase_zgemm(p, L, lds);
  xcd_barrier(xb);
  phase_rows(p, L);
  xcd_barrier(xb);
  phase_mix(p, L, lds);
  xcd_barrier(xb);
  phase_attn(p, L, lds);
  xcd_barrier(xb);
  phase_out<L>(p, lds);
  xcd_barrier(xb);
}

__global__ void __launch_bounds__(512, 2) fwd_megakernel(Params p) {
  __shared__ __attribute__((aligned(16))) char lds[LDS_BYTES];
  __shared__ uint4 xb_words;
  cg::grid_group grid = cg::this_grid();
  if (threadIdx.x == 0) xb_words = make_uint4(0u, 0u, 0u, 0u);
  __syncthreads();
  const XcdBarrier xb = xcd_barrier_post((unsigned*)(p.ws + OFF_BAR), (volatile XLAS unsigned*)&xb_words);
  grid.sync();
  phase_prep(p, lds);
  xcd_barrier(xb);
  layer_phases<0>(p, lds, xb);
  layer_phases<1>(p, lds, xb);
  phase_ln(p, 2);
}

extern "C" void kernel_launch(void* const* d_in, const int* in_sizes, int n_in, void* d_out, int out_size, void* d_ws, size_t ws_size, hipStream_t stream) {
  static int grid_blocks = 0;
  if (!grid_blocks) {
    int dev = 0, cus = 0, per_cu = 0;
    (void)hipGetDevice(&dev);
    (void)hipDeviceGetAttribute(&cus, hipDeviceAttributeMultiprocessorCount, dev);
    (void)hipOccupancyMaxActiveBlocksPerMultiprocessor(&per_cu, fwd_megakernel, NTH, 0);
    if (per_cu < 1) per_cu = 1;
    grid_blocks = cus;
  }
  if (ws_size < WS_NEED) { fprintf(stderr, "workspace too small: %zu < %zu\n", ws_size, (size_t)WS_NEED); return; }
  Params p{};
  const float** f = (const float**)&p;
  for (int i = 0; i < 27; ++i) f[i] = (const float*)d_in[i];
  p.out = (float*)d_out;
  p.ws = (char*)d_ws;
  void* args[] = {&p};
  (void)hipMemsetAsync((char*)d_ws + OFF_BAR, 0, XCD_BAR_WORDS * 4, stream);
  hipError_t e = hipLaunchCooperativeKernel((void*)fwd_megakernel, dim3(grid_blocks), dim3(NTH), args, 0, stream);
  if (e != hipSuccess) fprintf(stderr, "cooperative launch failed: %s (grid %d)\n", hipGetErrorString(e), grid_blocks);
}
```

```cpp
#include <hip/hip_runtime.h>
#include <hip/hip_cooperative_groups.h>
#include <cstdio>
#include <cstdint>
namespace cg = cooperative_groups;

#define DI __device__ __forceinline__
typedef unsigned short bf16_t;
typedef short bf16x8 __attribute__((ext_vector_type(8)));
typedef float f32x16 __attribute__((ext_vector_type(16)));
typedef float f32x4 __attribute__((ext_vector_type(4)));
typedef float f32x2 __attribute__((ext_vector_type(2)));
typedef __bf16 bf16x2_t __attribute__((ext_vector_type(2)));
typedef unsigned u32x4 __attribute__((ext_vector_type(4)));
typedef unsigned u32x2 __attribute__((ext_vector_type(2)));

constexpr int TP = 32768, TS = 128, T = TP + TS, SEQ = 16384, DM = 1024;
constexpr int PAST = 2048, SKV = PAST + 16;
constexpr int SKVP = 2112;
constexpr int SROWS = 8 * SKVP;
constexpr int NTH = 512;
constexpr int ZLD = 2816;
constexpr int ZC_U = 0, ZC_V = 256, ZC_GA = 512, ZC_GLU = 768, ZC_GB = 1280, ZC_CQ = 1536, ZC_CKV = 1920, ZC_GC = 2176, ZC_KR = 2688;
constexpr float LN_EPS = 1e-5f, RMS_EPS = 1e-6f;
constexpr float ALPHA = 1.41421356237309515f;
constexpr float QSCALE = 0.10206207261596577f * 1.4426950408889634f;

constexpr size_t O_YP = 0, O_YS = 33554432, O_PCONV = 33685504, O_PLAT = 33716224, O_PKR = 50493440,
                 O_SCONV = 52590592, O_SLAT = 52713472, O_SKR = 52779008, O_SV = 52787200;

constexpr size_t al256(size_t x) { return (x + 255) & ~(size_t)255; }
constexpr size_t OFF_WIN = 0;
constexpr size_t OFF_WUQ = OFF_WIN + al256((size_t)2 * 2816 * 1024 * 2);
constexpr size_t OFF_WUKV = OFF_WUQ + al256((size_t)2 * 768 * 384 * 2);
constexpr size_t OFF_WOUT = OFF_WUKV + al256((size_t)2 * 1024 * 256 * 2);
constexpr size_t OFF_WPW = OFF_WOUT + al256((size_t)2 * 1024 * 1024 * 2);
constexpr size_t OFF_WSB = OFF_WPW + al256((size_t)2 * 256 * 256 * 2);
constexpr size_t OFF_MOD = OFF_WSB + al256((size_t)2 * 4 * 128 * 128 * 2);
constexpr size_t OFF_CS = OFF_MOD + al256((size_t)2 * 10 * 3072 * 4);
constexpr size_t OFF_Z = OFF_CS + al256((size_t)16384 * 16 * 8);
constexpr size_t OFF_H = OFF_Z + al256((size_t)T * ZLD * 2);
constexpr size_t OFF_YMIX = OFF_H + al256((size_t)T * 1024 * 2);
constexpr size_t OFF_KP = OFF_YMIX + al256((size_t)T * 1024 * 2);
constexpr size_t OFF_VTP = OFF_KP + al256((size_t)TP * 512 * 2);
constexpr size_t OFF_LATS = OFF_VTP + al256((size_t)TP * 512 * 2);
constexpr size_t OFF_KRS = OFF_LATS + al256((size_t)2 * SROWS * 256 * 2);
constexpr size_t OFF_KS = OFF_KRS + al256((size_t)2 * SROWS * 32 * 2);
constexpr size_t OFF_VTS = OFF_KS + al256((size_t)SROWS * 512 * 2);
constexpr size_t OFF_KRP = OFF_VTS + al256((size_t)512 * SROWS * 2);
constexpr size_t OFF_BAR = OFF_KRP + al256((size_t)TP * 32 * 2);
constexpr size_t OFF_STATS = OFF_BAR + 16384;
constexpr size_t WS_NEED = OFF_STATS + al256((size_t)T * 2 * 4);

struct Params {
  const float *x_prompt, *x_sample, *cache_latent, *cache_krope, *state_conv, *c_prompt, *c_sample;
  const float *w_ada, *b_ada, *w_in, *gmlp_ln_g, *gmlp_ln_b, *gmlp_ws, *gmlp_bs, *conv_dw_k, *conv_dw_b, *conv_ln_g, *conv_ln_b,
      *conv_w_pw, *conv_b_pw, *mla_q_norm, *mla_w_uq, *mla_kv_norm, *mla_w_ukv, *w_out, *post_ln_g, *post_ln_b;
  float* out;
  char* ws;
};

DI unsigned pk2(float a, float b) { f32x2 v = {a, b}; return __builtin_bit_cast(unsigned, __builtin_convertvector(v, bf16x2_t)); }
DI bf16_t f2bf(float a) { return (bf16_t)(pk2(a, 0.f) & 0xffffu); }
DI float bflo(unsigned u) { return __uint_as_float(u << 16); }
DI float bfhi(unsigned u) { return __uint_as_float(u & 0xffff0000u); }
DI float bf2f(bf16_t v) { return __uint_as_float((unsigned)v << 16); }
DI float sigmoidf_(float x) { return __builtin_amdgcn_rcpf(1.0f + __builtin_amdgcn_exp2f(-1.4426950408889634f * x)); }
DI float siluf_(float x) { return x * sigmoidf_(x); }
DI float geluf_(float x) { const float y = x * (0.7978845608028654f + 0.0356774081363001f * x * x); return x * sigmoidf_(2.0f * y); }
DI float wsum(float v) {
#pragma unroll
  for (int o = 32; o > 0; o >>= 1) v += __shfl_xor(v, o);
  return v;
}
DI f32x16 mfma32(bf16x8 a, bf16x8 b, f32x16 c) { return __builtin_amdgcn_mfma_f32_32x32x16_bf16(a, b, c, 0, 0, 0); }
DI f32x16 zero16() { f32x16 z; for (int i = 0; i < 16; ++i) z[i] = 0.f; return z; }
DI int swap23(int x) { return (x & ~12) | ((x & 4) << 1) | ((x & 8) >> 1); }
DI int mod_row(int t) { return t < TP ? (t >> 14) : 2 + ((t - TP) >> 4); }
DI int tok_pos(int t) { return t < TP ? (t & (SEQ - 1)) : PAST + ((t - TP) & 15); }

DI int otid() { int t = threadIdx.x; asm volatile("" : "+v"(t)); return t; }

template <class Epi> DI int epi_tag(const Epi& e, int colblk) { if constexpr (Epi::TAGGED) return e.tag(colblk); else return 0; }
template <class Epi> DI void epi_quad(const Epi& e, int row, int col, f32x4 v, int tag) { if constexpr (Epi::TAGGED) e.quad(row, col, v, tag); else e.quad(row, col, v); }
template <class Epi> DI void epi_rope(const Epi& e, int row, int colblk, int i0, f32x4 x1, f32x4 x2) { if constexpr (Epi::ROPE) e.rope(row, colblk, i0, x1, x2); }

namespace g256 {
constexpr int BK = 64, HALF = 128, HT = HALF * BK;
DI int lds_byte(int r, int c) { const int st = (r >> 4) * 2 + (c >> 5), rr = r & 15, cc = c & 31, ob = rr * 64 + cc * 2; return st * 1024 + (ob ^ (((ob >> 9) & 1) << 5)); }
DI void stage_rc(int b, int& R, int& C) { const int st = b / 1024, sb = b % 1024, swz = sb ^ (((sb >> 9) & 1) << 5); R = (st >> 1) * 16 + swz / 64; C = (st & 1) * 32 + (swz % 64) / 2; }

#define LAS __attribute__((address_space(3)))
DI bool unit_of(int L, int nM, int nN, int& pm, int& pn) {
  const int nwg = nM * nN;
  if (L >= nwg) return false;
  int wgid = L;
  { const int q = nwg / 8, r = nwg % 8, xcd = wgid % 8, off = wgid / 8; wgid = (xcd < r ? xcd * (q + 1) : r * (q + 1) + (xcd - r) * q) + off; }
  const int nig = 8 * nN, gid = wgid / nig, fm = gid * 8, gsz = (nM - fm) < 8 ? (nM - fm) : 8;
  pm = fm + ((wgid % nig) % gsz); pn = (wgid % nig) / gsz;
  return true;
}
template <class Epi>
DI void phase(const bf16_t* __restrict__ A, int lda, const bf16_t* __restrict__ Bt, int ldb, int K, int M, int N, int first, char* shmc, const Epi& epi) {
  const int nM = M / 256, nN = N / 256, G = gridDim.x;
  int L = first, pm, pn;
  if (!unit_of(L, nM, nN, pm, pn)) return;
  LAS unsigned char* lds = (LAS unsigned char*)shmc;
  int tidv = threadIdx.x;
  asm volatile("" : "+v"(tidv));
  constexpr int HTB = HT * 2;
#define SA(b, h) (((b) * 2 + (h)) * HTB)
#define SB(b, h) ((4 + (b) * 2 + (h)) * HTB)
#define STAGE(bufoff, gbase, voff) do { _Pragma("unroll") for (int _i = 0; _i < 2; ++_i) \
    __builtin_amdgcn_global_load_lds((const unsigned*)((const char*)(gbase) + (voff)[_i]), (LAS unsigned*)(lds + (bufoff) + ldsw + _i * 8192), 16, 0, 0); } while (0)
#define LDA(dst, b, h) do { _Pragma("unroll") for (int m = 0; m < 4; ++m) _Pragma("unroll") for (int k = 0; k < 2; ++k) dst[m][k] = *(const LAS bf16x8*)(lds + SA(b, h) + aoff + m * 2048 + k * 1024); } while (0)
#define LDB(dst, b, h) do { _Pragma("unroll") for (int n = 0; n < 2; ++n) _Pragma("unroll") for (int k = 0; k < 2; ++k) dst[n][k] = *(const LAS bf16x8*)(lds + SB(b, h) + boff + n * 2048 + k * 1024); } while (0)
#define MMA(ai, bj, At_, Bt_) do { __builtin_amdgcn_s_setprio(1); _Pragma("unroll") for (int m = 0; m < 4; ++m) _Pragma("unroll") for (int n = 0; n < 2; ++n) _Pragma("unroll") for (int k = 0; k < 2; ++k) \
      acc[ai][bj][m][n] = __builtin_amdgcn_mfma_f32_16x16x32_bf16(Bt_[n][k], At_[m][k], acc[ai][bj][m][n], 0, 0, 0); \
    __builtin_amdgcn_s_setprio(0); } while (0)
#define WAIT_V(n) asm volatile("s_waitcnt vmcnt(" #n ")" ::: "memory")
#define WAIT_L(n) asm volatile("s_waitcnt lgkmcnt(" #n ")" ::: "memory")
#define BAR __builtin_amdgcn_s_barrier()
#define SCHED __builtin_amdgcn_sched_barrier(0)
  const int wid = __builtin_amdgcn_readfirstlane(tidv >> 6), lane = tidv & 63, wr = wid >> 2, wc = wid & 3, fr = lane & 15, fq = lane >> 4;
  const int aoff = lds_byte(wr * 64 + fr, fq * 8), boff = lds_byte(wc * 32 + fr, fq * 8);
  const unsigned ldsw = (unsigned)wid * 1024u;
  unsigned voffA[2], voffB[2];
#pragma unroll
  for (int i = 0; i < 2; ++i) { int R, C; stage_rc(tidv * 16 + i * 8192, R, C); voffA[i] = (unsigned)(R * lda + C) * 2u; voffB[i] = (unsigned)(R * ldb + C) * 2u; }
  const size_t hA = (size_t)HALF * lda * 2, hB = (size_t)HALF * ldb * 2;
  const char* cA = (const char*)A + (size_t)pm * 2 * hA; const char* cB = (const char*)Bt + (size_t)pn * 2 * hB;
  constexpr int kstep = BK * 2;
  f32x4 acc[2][2][4][2];
#pragma unroll
  for (int i = 0; i < 2; ++i)
#pragma unroll
    for (int j = 0; j < 2; ++j)
#pragma unroll
      for (int m = 0; m < 4; ++m)
#pragma unroll
        for (int n = 0; n < 2; ++n) acc[i][j][m][n] = (f32x4){0.f, 0.f, 0.f, 0.f};
  bf16x8 At[4][2], B0[2][2], B1[2][2];
  const int nt = K / BK;
  STAGE(SB(0, 0), cB, voffB); STAGE(SB(0, 1), cB + hB, voffB); STAGE(SA(0, 0), cA, voffA); STAGE(SA(0, 1), cA + hA, voffA);
  if (wr == 1) BAR;
  WAIT_V(2); BAR;
  STAGE(SB(1, 0), cB + kstep, voffB); STAGE(SA(1, 0), cA + kstep, voffA); STAGE(SB(1, 1), cB + hB + kstep, voffB);
  WAIT_V(6); BAR;
  for (;;) {
    int npm, npn;
    const bool has_next = unit_of(L + G, nM, nN, npm, npn);
    const char* nA = has_next ? (const char*)A + (size_t)npm * 2 * hA : cA; const char* nB = has_next ? (const char*)Bt + (size_t)npn * 2 * hB : cB;
    for (int t = 0; t < nt; t += 2) {
      const bool last = (t == nt - 2);
      const char* a1 = cA + (size_t)(t + 1) * kstep;
      const char* a2 = last ? nA : cA + (size_t)(t + 2) * kstep; const char* b2 = last ? nB : cB + (size_t)(t + 2) * kstep;
      const char* a3 = a2 + kstep; const char* b3 = b2 + kstep;
      LDB(B0, 0, 0); LDB(B1, 0, 1); SCHED; LDA(At, 0, 0); STAGE(SA(1, 1), a1 + hA, voffA);
      WAIT_V(8); WAIT_L(0); BAR; MMA(0, 0, At, B0); MMA(0, 1, At, B1); BAR; SCHED;
      LDA(At, 0, 1); STAGE(SB(0, 0), b2, voffB); STAGE(SB(0, 1), b2 + hB, voffB); STAGE(SA(0, 0), a2, voffA);
      WAIT_V(8); WAIT_L(0); BAR; MMA(1, 0, At, B0); MMA(1, 1, At, B1); BAR; SCHED;
      LDB(B0, 1, 0); LDB(B1, 1, 1); SCHED; LDA(At, 1, 0); STAGE(SA(0, 1), a2 + hA, voffA);
      WAIT_V(8); WAIT_L(0); BAR; MMA(0, 0, At, B0); MMA(0, 1, At, B1); BAR; SCHED;
      LDA(At, 1, 1); STAGE(SB(1, 0), b3, voffB); STAGE(SB(1, 1), b3 + hB, voffB); STAGE(SA(1, 0), a3, voffA);
      WAIT_V(8); WAIT_L(0); BAR; MMA(1, 0, At, B0); MMA(1, 1, At, B1); BAR; SCHED;
    }
    const int brow = pm * 256, bcol = pn * 256;
#pragma unroll
    for (int ai = 0; ai < 2; ++ai)
#pragma unroll
      for (int bj = 0; bj < 2; ++bj) {
        const int colblk = bcol + bj * HALF + wc * 32;
        const int tag = epi_tag(epi, colblk);
#pragma unroll
        for (int m = 0; m < 4; ++m) {
          const int row = brow + ai * HALF + wr * 64 + m * 16 + fr;
          if (Epi::ROPE && (colblk % 96) == 64) epi_rope(epi, row, colblk, fq * 4, acc[ai][bj][m][0], acc[ai][bj][m][1]);
          else { epi_quad(epi, row, colblk + fq * 4, acc[ai][bj][m][0], tag); epi_quad(epi, row, colblk + 16 + fq * 4, acc[ai][bj][m][1], tag); }
        }
      }
    if (!has_next) break;
#pragma unroll
    for (int i = 0; i < 2; ++i)
#pragma unroll
      for (int j = 0; j < 2; ++j)
#pragma unroll
        for (int m = 0; m < 4; ++m)
#pragma unroll
          for (int n = 0; n < 2; ++n) acc[i][j][m][n] = (f32x4){0.f, 0.f, 0.f, 0.f};
    pm = npm; pn = npn; cA = nA; cB = nB; L += G;
  }
  WAIT_V(0);
  if (wr == 0) BAR;
  BAR;
#undef SA
#undef SB
#undef STAGE
#undef LDA
#undef LDB
#undef MMA
#undef WAIT_V
#undef WAIT_L
#undef BAR
#undef SCHED
}
}

constexpr int GROW = 144;
constexpr int GA_T = 128 * GROW, GB_T = 256 * GROW, GSTAGE = GA_T + GB_T;
constexpr int LDS_BYTES = 131072;

template <class Epi>
DI void gemm_tile8(const bf16_t* __restrict__ A, int lda, const bf16_t* __restrict__ Bt, int ldb, int K, int m0, int n0, char* lds, const Epi& epi) {
  const int tx = otid();
  const int tid = tx, lane = tid & 63, w = __builtin_amdgcn_readfirstlane(tid >> 6), wm = w >> 2, wn = w & 3;
  const int lrow = tid >> 3, lkc = tid & 7;
  const bf16_t* ag = A + (size_t)(m0 + lrow) * lda + lkc * 8;
  const bf16_t* bg = Bt + (size_t)(n0 + lrow) * ldb + lkc * 8;
  u32x4 ra0[2], rb0[4], ra1[2], rb1[4];
#define T8_GLOAD(RA, RB, kt) do { _Pragma("unroll") for (int i = 0; i < 2; ++i) RA[i] = *(const u32x4*)(ag + (size_t)(64 * i) * lda + (kt) * 64); \
    _Pragma("unroll") for (int i = 0; i < 4; ++i) RB[i] = *(const u32x4*)(bg + (size_t)(64 * i) * ldb + (kt) * 64); } while (0)
#define T8_LSTORE(RA, RB, st) do { char* lw_ = lds + (st) * GSTAGE + lrow * GROW + lkc * 16; _Pragma("unroll") for (int i = 0; i < 2; ++i) *(u32x4*)(lw_ + 64 * i * GROW) = RA[i]; \
    _Pragma("unroll") for (int i = 0; i < 4; ++i) *(u32x4*)(lw_ + GA_T + 64 * i * GROW) = RB[i]; } while (0)
  const int nk = K >> 6;
  T8_GLOAD(ra0, rb0, 0);
  T8_GLOAD(ra1, rb1, 1);
  T8_LSTORE(ra0, rb0, 0);
  __syncthreads();
  f32x16 acc[2][2];
#pragma unroll
  for (int i = 0; i < 2; ++i)
#pragma unroll
    for (int j = 0; j < 2; ++j) acc[i][j] = zero16();
  const int fro = (lane & 31) * GROW + (lane >> 5) * 16;
#define T8_MMA(st) do { const char* sa = lds + (st) * GSTAGE + wm * 64 * GROW + fro; const char* sb = lds + (st) * GSTAGE + GA_T + wn * 64 * GROW + fro; \
    _Pragma("unroll") for (int s = 0; s < 4; ++s) { \
      const bf16x8 a0 = *(const bf16x8*)(sa + s * 32), a1 = *(const bf16x8*)(sa + 32 * GROW + s * 32); \
      const bf16x8 b0 = *(const bf16x8*)(sb + s * 32), b1 = *(const bf16x8*)(sb + 32 * GROW + s * 32); \
      acc[0][0] = mfma32(b0, a0, acc[0][0]); acc[0][1] = mfma32(b1, a0, acc[0][1]); acc[1][0] = mfma32(b0, a1, acc[1][0]); acc[1][1] = mfma32(b1, a1, acc[1][1]); } } while (0)
  for (int kt = 0; kt < nk; kt += 2) {
    if (kt + 2 < nk) T8_GLOAD(ra0, rb0, kt + 2);
    __builtin_amdgcn_sched_barrier(0);
    T8_MMA(0);
    __builtin_amdgcn_sched_barrier(0);
    T8_LSTORE(ra1, rb1, 1);
    __syncthreads();
    if (kt + 3 < nk) T8_GLOAD(ra1, rb1, kt + 3);
    __builtin_amdgcn_sched_barrier(0);
    T8_MMA(1);
    __builtin_amdgcn_sched_barrier(0);
    if (kt + 2 < nk) T8_LSTORE(ra0, rb0, 0);
    __syncthreads();
  }
#undef T8_GLOAD
#undef T8_LSTORE
#undef T8_MMA
  const int hh = lane >> 5;
#pragma unroll
  for (int i = 0; i < 2; ++i)
#pragma unroll
    for (int j = 0; j < 2; ++j) {
      const int row = m0 + wm * 64 + i * 32 + (lane & 31), nb = n0 + wn * 64 + j * 32;
      const f32x16& a = acc[i][j];
      if (Epi::ROPE && (nb % 96) == 64) {
#pragma unroll
        for (int g = 0; g < 2; ++g)
          epi_rope(epi, row, nb, 8 * g + 4 * hh, (f32x4){a[4 * g], a[4 * g + 1], a[4 * g + 2], a[4 * g + 3]}, (f32x4){a[4 * g + 8], a[4 * g + 9], a[4 * g + 10], a[4 * g + 11]});
      } else {
#pragma unroll
        for (int g = 0; g < 4; ++g) epi_quad(epi, row, nb + 8 * g + 4 * hh, (f32x4){a[4 * g], a[4 * g + 1], a[4 * g + 2], a[4 * g + 3]}, epi_tag(epi, nb));
      }
    }
}

DI void transpose_unit(const float* __restrict__ src, int lds_src, bf16_t* __restrict__ dst, int K, int k0, int n0, int kind, char* lds, int tid) {
  float* tile = (float*)lds;
  const int nn = tid & 63, kq = tid >> 6;
  const int np = n0 + nn;
  int sc;
  if (kind == 0) { sc = np < 2176 ? np : (np < 2688 ? np + 32 : (np < 2720 ? np - 512 : -1)); }
  else if (kind == 2) { sc = np < 512 ? ((np >> 6) * 128 + (np & 63)) : (((np - 512) >> 6) * 128 + 64 + (np & 63)); }
  else sc = np;
#pragma unroll 4
  for (int i = 0; i < 16; ++i) {
    const int kk = kq * 16 + i;
    tile[kk * 65 + nn] = sc >= 0 ? src[(size_t)(k0 + kk) * lds_src + sc] : 0.f;
  }
  __syncthreads();
  const int kk = tid & 63, nq = tid >> 6;
#pragma unroll 4
  for (int i = 0; i < 16; ++i) {
    const int n2 = nq * 16 + i;
    dst[(size_t)(n0 + n2) * K + k0 + kk] = f2bf(tile[kk * 65 + n2]);
  }
  __syncthreads();
}

DI void mod_unit(const Params& p, int l, int cg0, char* lds, int tid) {
  float* sc = (float*)lds;
  float* red = sc + 10 * 1024;
  for (int e = tid; e < 10 * 1024; e += 256) {
    const int r = e >> 10, k = e & 1023;
    const float c = r < 2 ? p.c_prompt[r * 1024 + k] : p.c_sample[(r - 2) * 1024 + k];
    sc[e] = siluf_(c);
  }
  __syncthreads();
  const int col = cg0 * 32 + (tid & 31), kg = tid >> 5;
  float acc[10];
#pragma unroll
  for (int r = 0; r < 10; ++r) acc[r] = 0.f;
  const float* wp = p.w_ada + (size_t)l * 1024 * 3072 + col;
  for (int k = kg * 128; k < kg * 128 + 128; ++k) {
    const float wv = wp[(size_t)k * 3072];
#pragma unroll
    for (int r = 0; r < 10; ++r) acc[r] += sc[r * 1024 + k] * wv;
  }
#pragma unroll
  for (int r = 0; r < 10; ++r) red[(kg * 10 + r) * 32 + (tid & 31)] = acc[r];
  __syncthreads();
  float* mod = (float*)(p.ws + OFF_MOD);
  for (int e = tid; e < 320; e += 256) {
    const int r = e >> 5, c = e & 31;
    float s = 0.f;
#pragma unroll
    for (int g = 0; g < 8; ++g) s += red[(g * 10 + r) * 32 + c];
    mod[((size_t)l * 10 + r) * 3072 + cg0 * 32 + c] = s + p.b_ada[l * 3072 + cg0 * 32 + c];
  }
  __syncthreads();
}

DI void prep_weights(const Params& p, int l, int j, int nwg, char* lds) {
  const int tx = otid();
  constexpr int PER_L = 704 + 72 + 64 + 256 + 16;
  const int half = tx >> 8, tid = tx & 255;
  char* hl = lds + half * 65536;
  for (int up = j; up < PER_L / 2; up += nwg) {
    int v = up * 2 + half;
    if (v < 704) { transpose_unit(p.w_in + (size_t)l * 1024 * 2720, 2720, (bf16_t*)(p.ws + OFF_WIN) + (size_t)l * 2816 * 1024, 1024, (v % 16) * 64, (v / 16) * 64, 0, hl, tid); continue; }
    v -= 704;
    if (v < 72) { transpose_unit(p.mla_w_uq + (size_t)l * 384 * 768, 768, (bf16_t*)(p.ws + OFF_WUQ) + (size_t)l * 768 * 384, 384, (v % 6) * 64, (v / 6) * 64, 1, hl, tid); continue; }
    v -= 72;
    if (v < 64) { transpose_unit(p.mla_w_ukv + (size_t)l * 256 * 1024, 1024, (bf16_t*)(p.ws + OFF_WUKV) + (size_t)l * 1024 * 256, 256, (v % 4) * 64, (v / 4) * 64, 2, hl, tid); continue; }
    v -= 64;
    if (v < 256) { transpose_unit(p.w_out + (size_t)l * 1024 * 1024, 1024, (bf16_t*)(p.ws + OFF_WOUT) + (size_t)l * 1024 * 1024, 1024, (v % 16) * 64, (v / 16) * 64, 1, hl, tid); continue; }
    v -= 256;
    transpose_unit(p.conv_w_pw + (size_t)l * 256 * 256, 256, (bf16_t*)(p.ws + OFF_WPW) + (size_t)l * 256 * 256, 256, (v % 4) * 64, (v / 4) * 64, 1, hl, tid);
  }
}

DI void phase_prep(const Params& p, char* lds) {
  const int tx = otid();
  const int half = tx >> 8, tid = tx & 255;
  char* hl = lds + half * 65536;
  prep_weights(p, 0, blockIdx.x, gridDim.x, lds);
  for (int up = blockIdx.x; up < 96; up += gridDim.x) { const int v = up * 2 + half; mod_unit(p, v / 96, v % 96, hl, tid); }
  const size_t gt = (size_t)blockIdx.x * NTH + tx, gn = (size_t)gridDim.x * NTH;
  {
    bf16_t* wsb = (bf16_t*)(p.ws + OFF_WSB);
    for (size_t e = gt; e < (size_t)2 * 4 * 128 * 128; e += gn) {
      const int j = e & 127, i = (e >> 7) & 127;
      wsb[e] = f2bf(((j >> 6) <= (i >> 6)) ? p.gmlp_ws[e] : 0.f);
    }
  }
  {
    bf16_t* lats = (bf16_t*)(p.ws + OFF_LATS);
    for (size_t e = gt; e < (size_t)2 * 8 * PAST * 64; e += gn) {
      const size_t c4 = e & 63, row = (e >> 6) & (PAST - 1), lb = e >> 17;
      const f32x4 v = *(const f32x4*)(p.cache_latent + e * 4);
      u32x2 o; o.x = pk2(v[0], v[1]); o.y = pk2(v[2], v[3]);
      *(u32x2*)(lats + (lb * SKVP + row) * 256 + c4 * 4) = o;
    }
    bf16_t* krs = (bf16_t*)(p.ws + OFF_KRS);
    for (size_t e = gt; e < (size_t)2 * 8 * PAST * 8; e += gn) {
      const size_t c4 = e & 7, row = (e >> 3) & (PAST - 1), lb = e >> 14;
      const f32x4 v = *(const f32x4*)(p.cache_krope + e * 4);
      u32x2 o; o.x = pk2(v[0], v[1]); o.y = pk2(v[2], v[3]);
      *(u32x2*)(krs + (lb * SKVP + row) * 32 + c4 * 4) = o;
    }
    for (size_t e = gt; e < (size_t)16 * 48 * 64; e += gn) {
      const size_t c4 = e & 63, row = (e >> 6) % 48, lb = e / (48 * 64);
      *(u32x2*)(lats + (lb * SKVP + SKV + row) * 256 + c4 * 4) = (u32x2){0u, 0u};
    }
    for (size_t e = gt; e < (size_t)16 * 48 * 8; e += gn) {
      const size_t c4 = e & 7, row = (e >> 3) % 48, lb = e / (48 * 8);
      *(u32x2*)(krs + (lb * SKVP + SKV + row) * 32 + c4 * 4) = (u32x2){0u, 0u};
    }
  }
  {
    f32x2* cs = (f32x2*)(p.ws + OFF_CS);
    for (size_t e = gt; e < (size_t)16384 * 16; e += gn) {
      const int i = e & 15, pos = (int)(e >> 4);
      const double invrev = exp2(-(double)i * (13.287712379549449 / 16.0)) * 0.15915494309189535;
      double rev = (double)pos * invrev;
      rev -= rint(rev);
      const float fr = (float)rev;
      f32x2 o; o.x = __builtin_amdgcn_cosf(fr); o.y = __builtin_amdgcn_sinf(fr);
      cs[e] = o;
    }
  }
  {
    for (size_t e = gt; e < (size_t)16 * 14 * 256; e += gn) {
      const size_t c = e & 255, j = (e >> 8) % 14, lb = e / (14 * 256);
      p.out[O_SCONV + (lb * 30 + j) * 256 + c] = p.state_conv[(lb * 30 + 16 + j) * 256 + c];
    }
  }
}

DI void phase_ln(const Params& p, int mode) {
  const int tx = otid();
  const int lane = tx & 63;
  const int gw = blockIdx.x * 8 + (tx >> 6), nw = gridDim.x * 8;
  const float* r = p.out;
  bf16_t* hb = (bf16_t*)(p.ws + OFF_H);
  const float* mod = (const float*)(p.ws + OFF_MOD);
  auto rowsrc = [&](int t) { return mode == 0 ? (t < TP ? p.x_prompt + (size_t)t * 1024 : p.x_sample + (size_t)(t - TP) * 1024) : r + (size_t)t * 1024; };
  f32x4 vn[4];
  if (gw < T) {
#pragma unroll
    for (int i = 0; i < 4; ++i) vn[i] = *(const f32x4*)(rowsrc(gw) + lane * 4 + 256 * i);
  }
  for (int t = gw; t < T; t += nw) {
    f32x4 v[4];
#pragma unroll
    for (int i = 0; i < 4; ++i) v[i] = vn[i];
    if (t + nw < T) {
#pragma unroll
      for (int i = 0; i < 4; ++i) vn[i] = *(const f32x4*)(rowsrc(t + nw) + lane * 4 + 256 * i);
    }
    __builtin_amdgcn_sched_barrier(0);
    float s = 0.f;
#pragma unroll
    for (int i = 0; i < 4; ++i) s += (v[i][0] + v[i][1]) + (v[i][2] + v[i][3]);
    float mu = wsum(s) * (1.0f / 1024.0f);
    float q = 0.f;
#pragma unroll
    for (int i = 0; i < 4; ++i) { const f32x4 d = v[i] - mu; q += (d[0] * d[0] + d[1] * d[1]) + (d[2] * d[2] + d[3] * d[3]); }
    float rstd = rsqrtf(wsum(q) * (1.0f / 1024.0f) + LN_EPS);
    if (mode >= 1) {
      const int pl = mode - 1;
      s = 0.f;
#pragma unroll
      for (int i = 0; i < 4; ++i) {
        const f32x4 g = *(const f32x4*)(p.post_ln_g + pl * 1024 + lane * 4 + 256 * i), b = *(const f32x4*)(p.post_ln_b + pl * 1024 + lane * 4 + 256 * i);
        v[i] = (v[i] - mu) * rstd * g + b;
        if (mode == 2) *(f32x4*)(p.out + (size_t)t * 1024 + lane * 4 + 256 * i) = v[i];
        s += (v[i][0] + v[i][1]) + (v[i][2] + v[i][3]);
      }
      if (mode == 2) continue;
      if (lane == 0) *(f32x2*)((float*)(p.ws + OFF_STATS) + (size_t)t * 2) = (f32x2){mu, rstd};
      mu = wsum(s) * (1.0f / 1024.0f);
      q = 0.f;
#pragma unroll
      for (int i = 0; i < 4; ++i) { const f32x4 d = v[i] - mu; q += (d[0] * d[0] + d[1] * d[1]) + (d[2] * d[2] + d[3] * d[3]); }
      rstd = rsqrtf(wsum(q) * (1.0f / 1024.0f) + LN_EPS);
    }
    const int l = mode == 0 ? 0 : 1;
    const float* mr = mod + ((size_t)l * 10 + mod_row(t)) * 3072;
#pragma unroll
    for (int i = 0; i < 4; ++i) {
      const f32x4 sh = *(const f32x4*)(mr + lane * 4 + 256 * i), sc = *(const f32x4*)(mr + 1024 + lane * 4 + 256 * i);
      const f32x4 o = (v[i] - mu) * rstd * (1.0f + sc) + sh;
      u32x2 w; w.x = pk2(o[0], o[1]); w.y = pk2(o[2], o[3]);
      *(u32x2*)(hb + (size_t)t * 1024 + lane * 4 + 256 * i) = w;
    }
  }
}

struct EpiZ {
  static constexpr bool ROPE = false, TAGGED = true;
  bf16_t* z;
  DI int tag(int nb) const { return nb < 512 ? 1 : (nb < 768 ? 2 : (nb < 1280 ? 0 : (nb < 1536 ? 2 : (nb < 2176 ? 0 : (nb < 2688 ? 2 : 0))))); }
  DI void quad(int m, int n, f32x4 v, int act) const {
    if (act == 1) { v[0] = geluf_(v[0]); v[1] = geluf_(v[1]); v[2] = geluf_(v[2]); v[3] = geluf_(v[3]); }
    else if (act == 2) { v[0] = siluf_(v[0]); v[1] = siluf_(v[1]); v[2] = siluf_(v[2]); v[3] = siluf_(v[3]); }
    u32x2 w; w.x = pk2(v[0], v[1]); w.y = pk2(v[2], v[3]);
    *(u32x2*)(z + (size_t)m * ZLD + n) = w;
  }
};
DI void phase_zgemm(const Params& p, int l, char* lds) {
  const bf16_t* hb = (const bf16_t*)(p.ws + OFF_H);
  const bf16_t* wt = (const bf16_t*)(p.ws + OFF_WIN) + (size_t)l * 2816 * 1024;
  EpiZ epi{(bf16_t*)(p.ws + OFF_Z)};
  g256::phase(hb, 1024, wt, 1024, 1024, TP, 2816, blockIdx.x, lds, epi);
  const int G = gridDim.x;
  int v0 = (int)blockIdx.x - (1408 % G); if (v0 < 0) v0 += G;
  for (int v = v0; v < 11; v += G) gemm_tile8(hb, 1024, wt, 1024, 1024, TP, v * 256, lds, epi);
  if (l == 0 && G == 256 && blockIdx.x >= 128) prep_weights(p, 1, blockIdx.x - 128, 128, lds);
  else if (l == 0 && G != 256) prep_weights(p, 1, blockIdx.x, G, lds);
}

DI void phase_rows(const Params& p, int l) {
  const int tx = otid();
  const int lane = tx & 63;
  const int gw = blockIdx.x * 8 + (tx >> 6), nw = gridDim.x * 8;
  bf16_t* z = (bf16_t*)(p.ws + OFF_Z);
  const f32x2* cs = (const f32x2*)(p.ws + OFF_CS);
  struct Raw { u32x2 v, ga, gg, kv; unsigned q0, q1, q2; bf16_t k1, k2; };
  auto load_row = [&](int t) {
    const bf16_t* zr = z + (size_t)t * ZLD;
    Raw r;
    r.v = *(const u32x2*)(zr + ZC_V + lane * 4);
    r.ga = *(const u32x2*)(zr + ZC_GLU + lane * 4); r.gg = *(const u32x2*)(zr + ZC_GLU + 256 + lane * 4);
    const unsigned* cp = (const unsigned*)(zr + ZC_CQ + lane * 6);
    r.q0 = cp[0]; r.q1 = cp[1]; r.q2 = cp[2];
    r.kv = *(const u32x2*)(zr + ZC_CKV + lane * 4);
    r.k1 = zr[ZC_KR + (lane & 15)]; r.k2 = zr[ZC_KR + 16 + (lane & 15)];
    return r;
  };
  Raw rn;
  if (gw < T) rn = load_row(gw);
  for (int t = gw; t < T; t += nw) {
    const Raw rw = rn;
    if (t + nw < T) rn = load_row(t + nw);
    __builtin_amdgcn_sched_barrier(0);
    bf16_t* zr = z + (size_t)t * ZLD;
    const bool samp = t >= TP;
    const int sb = (t - TP) >> 4, si = (t - TP) & 15;
    const int pb = t >> 14, pos = tok_pos(t);
    {
      const u32x2 raw = rw.v;
      f32x4 v = {bflo(raw.x), bfhi(raw.x), bflo(raw.y), bfhi(raw.y)};
      const float mu = wsum((v[0] + v[1]) + (v[2] + v[3])) * (1.0f / 256.0f);
      const f32x4 d = v - mu;
      const float rstd = rsqrtf(wsum((d[0] * d[0] + d[1] * d[1]) + (d[2] * d[2] + d[3] * d[3])) * (1.0f / 256.0f) + LN_EPS);
      const f32x4 g = *(const f32x4*)(p.gmlp_ln_g + l * 256 + lane * 4), b = *(const f32x4*)(p.gmlp_ln_b + l * 256 + lane * 4);
      v = d * rstd * g + b;
      u32x2 w; w.x = pk2(v[0], v[1]); w.y = pk2(v[2], v[3]);
      *(u32x2*)(zr + ZC_V + lane * 4) = w;
      if (samp) *(f32x4*)(p.out + O_SV + ((size_t)(l * 8 + sb) * 16 + si) * 256 + lane * 4) = v;
    }
    {
      const u32x2 ra = rw.ga, rg = rw.gg;
      f32x4 g;
      g[0] = bflo(ra.x) * sigmoidf_(bflo(rg.x)); g[1] = bfhi(ra.x) * sigmoidf_(bfhi(rg.x));
      g[2] = bflo(ra.y) * sigmoidf_(bflo(rg.y)); g[3] = bfhi(ra.y) * sigmoidf_(bfhi(rg.y));
      u32x2 w; w.x = pk2(g[0], g[1]); w.y = pk2(g[2], g[3]);
      *(u32x2*)(zr + ZC_GLU + lane * 4) = w;
      if (samp) *(f32x4*)(p.out + O_SCONV + ((size_t)(l * 8 + sb) * 30 + 14 + si) * 256 + lane * 4) = g;
      else if (pos >= SEQ - 30) *(f32x4*)(p.out + O_PCONV + ((size_t)(l * 2 + pb) * 30 + (pos - (SEQ - 30))) * 256 + lane * 4) = g;
    }
    {
      const unsigned r0 = rw.q0, r1 = rw.q1, r2 = rw.q2;
      float v[6] = {bflo(r0), bfhi(r0), bflo(r1), bfhi(r1), bflo(r2), bfhi(r2)};
      float q = 0.f;
#pragma unroll
      for (int i = 0; i < 6; ++i) q += v[i] * v[i];
      const float rr = rsqrtf(wsum(q) * (1.0f / 384.0f) + RMS_EPS);
      const float* gq = p.mla_q_norm + l * 384 + lane * 6;
#pragma unroll
      for (int i = 0; i < 6; ++i) v[i] = v[i] * rr * gq[i];
      unsigned* op = (unsigned*)(zr + ZC_CQ + lane * 6);
      op[0] = pk2(v[0], v[1]); op[1] = pk2(v[2], v[3]); op[2] = pk2(v[4], v[5]);
    }
    {
      const u32x2 raw = rw.kv;
      f32x4 v = {bflo(raw.x), bfhi(raw.x), bflo(raw.y), bfhi(raw.y)};
      const float rr = rsqrtf(wsum((v[0] * v[0] + v[1] * v[1]) + (v[2] * v[2] + v[3] * v[3])) * (1.0f / 256.0f) + RMS_EPS);
      const f32x4 g = *(const f32x4*)(p.mla_kv_norm + l * 256 + lane * 4);
      v = v * rr * g;
      u32x2 w; w.x = pk2(v[0], v[1]); w.y = pk2(v[2], v[3]);
      if (samp) {
        *(f32x4*)(p.out + O_SLAT + ((size_t)(l * 8 + sb) * 16 + si) * 256 + lane * 4) = v;
        *(u32x2*)((bf16_t*)(p.ws + OFF_LATS) + ((size_t)(l * 8 + sb) * SKVP + PAST + si) * 256 + lane * 4) = w;
      } else {
        *(f32x4*)(p.out + O_PLAT + ((size_t)(l * 2 + pb) * SEQ + pos) * 256 + lane * 4) = v;
        *(u32x2*)(zr + ZC_CKV + lane * 4) = w;
      }
    }
    if (lane < 16) {
      const float x1 = bf2f(rw.k1), x2 = bf2f(rw.k2);
      const f32x2 c = cs[pos * 16 + lane];
      const float o1 = x1 * c.x - x2 * c.y, o2 = x1 * c.y + x2 * c.x;
      if (samp) {
        float* o = p.out + O_SKR + ((size_t)(l * 8 + sb) * 16 + si) * 32;
        o[lane] = o1; o[16 + lane] = o2;
        bf16_t* kb = (bf16_t*)(p.ws + OFF_KRS) + ((size_t)(l * 8 + sb) * SKVP + PAST + si) * 32;
        kb[lane] = f2bf(o1); kb[16 + lane] = f2bf(o2);
      } else {
        float* o = p.out + O_PKR + ((size_t)(l * 2 + pb) * SEQ + pos) * 32;
        o[lane] = o1; o[16 + lane] = o2;
        bf16_t* kb = (bf16_t*)(p.ws + OFF_KRP) + (size_t)t * 32;
        kb[lane] = f2bf(o1); kb[16 + lane] = f2bf(o2);
      }
    }
  }
}

struct EpiQ {
  static constexpr bool ROPE = false, TAGGED = false;
  bf16_t* q;
  DI void quad(int m, int n, f32x4 v) const {
    u32x2 w; w.x = pk2(v[0] * QSCALE, v[1] * QSCALE); w.y = pk2(v[2] * QSCALE, v[3] * QSCALE);
    *(u32x2*)(q + (size_t)m * 768 + n) = w;
  }
};
DI void rope_qfrag(bf16x8& f4, bf16x8& f5, const f32x2* cr) {
  u32x4 o4, o5;
#pragma unroll
  for (int j = 0; j < 8; j += 2) {
    const f32x2 ca = cr[j], cb = cr[j + 1];
    const float a1 = bf2f((bf16_t)f4[j]), a2 = bf2f((bf16_t)f5[j]), b1 = bf2f((bf16_t)f4[j + 1]), b2 = bf2f((bf16_t)f5[j + 1]);
    o4[j >> 1] = pk2(a1 * ca.x - a2 * ca.y, b1 * cb.x - b2 * cb.y);
    o5[j >> 1] = pk2(a1 * ca.y + a2 * ca.x, b1 * cb.y + b2 * cb.x);
  }
  f4 = __builtin_bit_cast(bf16x8, o4); f5 = __builtin_bit_cast(bf16x8, o5);
}
struct EpiStore {
  static constexpr bool ROPE = false, TAGGED = false;
  bf16_t* c; int ldc;
  DI void quad(int m, int n, f32x4 v) const {
    u32x2 w; w.x = pk2(v[0], v[1]); w.y = pk2(v[2], v[3]);
    *(u32x2*)(c + (size_t)m * ldc + n) = w;
  }
};
struct EpiKp {
  static constexpr bool ROPE = false, TAGGED = false;
  bf16_t* kp;
  DI void quad(int m, int n, f32x4 v) const {
    u32x2 w; w.x = pk2(v[0], v[1]); w.y = pk2(v[2], v[3]);
    *(u32x2*)(kp + (((size_t)(m >> 14) * 8 + (n >> 6)) * SEQ + (m & (SEQ - 1))) * 64 + (n & 63)) = w;
  }
};
struct EpiVt {
  static constexpr bool ROPE = false, TAGGED = false;
  bf16_t* vt;
  DI void quad(int m, int n, f32x4 v) const {
    const int b = n >> 14, pos = n & (SEQ - 1);
    u32x2 w; w.x = pk2(v[0], v[1]); w.y = pk2(v[2], v[3]);
    *(u32x2*)(vt + ((((size_t)(b * 8 + (m >> 6)) * 256 + (pos >> 6)) * 64 + (m & 63)) * 64 + swap23(pos & 63))) = w;
  }
};
struct EpiVts {
  static constexpr bool ROPE = false, TAGGED = false;
  bf16_t* vt;
  DI void quad(int m, int n, f32x4 v) const {
    u32x2 w; w.x = pk2(v[0], v[1]); w.y = pk2(v[2], v[3]);
    *(u32x2*)(vt + (size_t)m * SROWS + swap23(n)) = w;
  }
};

DI void gate_unit(const Params& p, int l, int ck, int hd, char* lds, int tid) {
  const int lane = tid & 63, w = tid >> 6;
  const bf16_t* z = (const bf16_t*)(p.ws + OFF_Z);
  const int t0 = ck * 128;
  constexpr int VROW = 272;
#pragma unroll
  for (int i = 0; i < 4; ++i) {
    const int c = tid + 256 * i, j = c >> 3, d0 = (c & 7) * 8;
    const u32x4 raw = *(const u32x4*)(z + (size_t)(t0 + j) * ZLD + ZC_V + hd * 64 + d0);
    bf16_t* dst = (bf16_t*)(lds + d0 * VROW) + j;
    dst[0 * (VROW / 2)] = (bf16_t)(raw.x & 0xffff); dst[1 * (VROW / 2)] = (bf16_t)(raw.x >> 16);
    dst[2 * (VROW / 2)] = (bf16_t)(raw.y & 0xffff); dst[3 * (VROW / 2)] = (bf16_t)(raw.y >> 16);
    dst[4 * (VROW / 2)] = (bf16_t)(raw.z & 0xffff); dst[5 * (VROW / 2)] = (bf16_t)(raw.z >> 16);
    dst[6 * (VROW / 2)] = (bf16_t)(raw.w & 0xffff); dst[7 * (VROW / 2)] = (bf16_t)(raw.w >> 16);
  }
  const bf16_t* wsb = (const bf16_t*)(p.ws + OFF_WSB) + ((size_t)(l * 4 + hd) * 128 + w * 32 + (lane & 31)) * 128 + (lane >> 5) * 8;
  bf16x8 afr[8];
#pragma unroll
  for (int s = 0; s < 8; ++s) afr[s] = *(const bf16x8*)(wsb + s * 16);
  __syncthreads();
  f32x16 a0 = zero16(), a1 = zero16();
  const char* vb = lds + (lane & 31) * VROW + (lane >> 5) * 16;
#pragma unroll
  for (int s = 0; s < 8; ++s) {
    if (s < 4 || w >= 2) {
      const bf16x8 b0 = *(const bf16x8*)(vb + s * 32), b1 = *(const bf16x8*)(vb + 32 * VROW + s * 32);
      a0 = mfma32(b0, afr[s], a0); a1 = mfma32(b1, afr[s], a1);
    }
  }
  const int i = w * 32 + (lane & 31), t = t0 + i, hh = lane >> 5;
  const float bs = p.gmlp_bs[(l * 4 + hd) * 128 + i];
  const bf16_t* zr = z + (size_t)t * ZLD;
  bf16_t* ym = (bf16_t*)(p.ws + OFF_YMIX) + (size_t)t * 1024;
#pragma unroll
  for (int jb = 0; jb < 2; ++jb)
#pragma unroll
    for (int g = 0; g < 4; ++g) {
      const int d = hd * 64 + jb * 32 + 8 * g + 4 * hh;
      const u32x2 u = *(const u32x2*)(zr + ZC_U + d), ga = *(const u32x2*)(zr + ZC_GA + d);
      const f32x16& a = jb ? a1 : a0;
      u32x2 o;
      o.x = pk2(bflo(u.x) * (a[4 * g] + bs) * bflo(ga.x), bfhi(u.x) * (a[4 * g + 1] + bs) * bfhi(ga.x));
      o.y = pk2(bflo(u.y) * (a[4 * g + 2] + bs) * bflo(ga.y), bfhi(u.y) * (a[4 * g + 3] + bs) * bfhi(ga.y));
      *(u32x2*)(ym + d) = o;
    }
  __syncthreads();
}

DI void sgate_unit(const Params& p, int l, int b, int c) {
  const int hd = c >> 6;
  const bf16_t* z = (const bf16_t*)(p.ws + OFF_Z) + (size_t)(TP + b * 16) * ZLD;
  float v[16];
#pragma unroll
  for (int j = 0; j < 16; ++j) v[j] = bf2f(z[(size_t)j * ZLD + ZC_V + c]);
  const float* ws = p.gmlp_ws + (size_t)(l * 4 + hd) * 128 * 128;
  bf16_t* ym = (bf16_t*)(p.ws + OFF_YMIX) + (size_t)(TP + b * 16) * 1024;
#pragma unroll 1
  for (int i = 0; i < 16; ++i) {
    float s = p.gmlp_bs[(l * 4 + hd) * 128 + i];
#pragma unroll
    for (int j = 0; j < 16; ++j) s += ws[i * 128 + j] * v[j];
    const float u = bf2f(z[(size_t)i * ZLD + ZC_U + c]), ga = bf2f(z[(size_t)i * ZLD + ZC_GA + c]);
    ym[(size_t)i * 1024 + c] = f2bf(u * s * ga);
  }
}

typedef __bf16 bf2v __attribute__((ext_vector_type(2)));
DI float dot2bf(unsigned a, unsigned b, float c) { return __builtin_amdgcn_fdot2_f32_bf16(__builtin_bit_cast(bf2v, a), __builtin_bit_cast(bf2v, b), c, false); }
DI void conv_unit(const Params& p, int l, int cu, char* lds, int tid) {
  const int lane = tid & 63, w = tid >> 6;
  int oz = 0; asm volatile("" : "+s"(oz));
  const bf16_t* z = (const bf16_t*)(p.ws + OFF_Z);
  const bool samp = cu >= 1024;
  const int ntok = samp ? 16 : 32;
  const int t0 = samp ? TP + (cu - 1024) * 16 : cu * 32;
  const int pos0 = samp ? 0 : (t0 & (SEQ - 1));
  constexpr int CROW = 136;
  char* xt = lds;
  float* yb = (float*)lds;
  char* ab = lds + 36864;
  const int nrows = ntok + 30;
  for (int c = tid; c < nrows * 32; c += 256) {
    const int j = c >> 5, ch = (c & 31) * 8;
    u32x4 v = {0u, 0u, 0u, 0u};
    if (samp) {
      if (j < 30) {
        const float* s = p.state_conv + ((size_t)(l * 8 + (cu - 1024)) * 30 + j) * 256 + ch;
        const f32x4 a = *(const f32x4*)s, b = *(const f32x4*)(s + 4);
        v.x = pk2(a[0], a[1]); v.y = pk2(a[2], a[3]); v.z = pk2(b[0], b[1]); v.w = pk2(b[2], b[3]);
      } else v = *(const u32x4*)(z + (size_t)(t0 + j - 30) * ZLD + ZC_GLU + ch);
    } else {
      if (pos0 + j - 30 >= 0) v = *(const u32x4*)(z + (size_t)(t0 + j - 30) * ZLD + ZC_GLU + ch);
    }
    bf16_t* dst = (bf16_t*)(xt + ch * CROW) + j;
    dst[0 * (CROW / 2)] = (bf16_t)(v.x & 0xffff); dst[1 * (CROW / 2)] = (bf16_t)(v.x >> 16);
    dst[2 * (CROW / 2)] = (bf16_t)(v.y & 0xffff); dst[3 * (CROW / 2)] = (bf16_t)(v.y >> 16);
    dst[4 * (CROW / 2)] = (bf16_t)(v.z & 0xffff); dst[5 * (CROW / 2)] = (bf16_t)(v.z >> 16);
    dst[6 * (CROW / 2)] = (bf16_t)(v.w & 0xffff); dst[7 * (CROW / 2)] = (bf16_t)(v.w >> 16);
  }
  unsigned WE[16], WO[16];
  {
    const float* wk = p.conv_dw_k + (size_t)l * 31 * 256 + tid + oz;
    float prev = 0.f;
#pragma unroll
    for (int j = 0; j < 16; ++j) {
      const float a = wk[(2 * j) * 256], b = (2 * j + 1 < 31) ? wk[(2 * j + 1) * 256] : 0.f;
      WE[j] = pk2(a, b); WO[j] = pk2(prev, a); prev = b;
    }
  }
  const float bias = p.conv_dw_b[l * 256 + tid + oz];
  __syncthreads();
  unsigned xr[32];
#pragma unroll
  for (int i = 0; i < 16; ++i) { const u32x2 v = *(const u32x2*)(xt + tid * CROW + i * 8); xr[2 * i] = v.x; xr[2 * i + 1] = v.y; }
  __syncthreads();
#pragma unroll
  for (int t = 0; t < 32; ++t) {
    if (t < ntok) {
      float acc = bias;
#pragma unroll
      for (int j = 0; j < 16; ++j) acc = dot2bf(xr[(t >> 1) + j], (t & 1) ? WO[j] : WE[j], acc);
      yb[t * 256 + tid] = acc;
    }
  }
  __builtin_amdgcn_sched_barrier(0);
  bf16x8 bfr[16][2];
  {
    const bf16_t* wp = (const bf16_t*)(p.ws + OFF_WPW) + (size_t)l * 256 * 256 + (size_t)(w * 64 + (lane & 31)) * 256 + (lane >> 5) * 8 + oz;
#pragma unroll
    for (int s = 0; s < 16; ++s) { bfr[s][0] = *(const bf16x8*)(wp + s * 16); bfr[s][1] = *(const bf16x8*)(wp + 32 * 256 + s * 16); }
  }
  __syncthreads();
  constexpr int AROW = 528;
  {
    const f32x4 g = *(const f32x4*)(p.conv_ln_g + l * 256 + lane * 4 + oz), b = *(const f32x4*)(p.conv_ln_b + l * 256 + lane * 4 + oz);
    for (int tt = w; tt < 32; tt += 4) {
      u32x2 o = {0u, 0u};
      if (tt < ntok) {
        const f32x4 v = *(const f32x4*)(yb + tt * 256 + lane * 4);
        const float mu = wsum((v[0] + v[1]) + (v[2] + v[3])) * (1.0f / 256.0f);
        const f32x4 d = v - mu;
        const float rstd = rsqrtf(wsum((d[0] * d[0] + d[1] * d[1]) + (d[2] * d[2] + d[3] * d[3])) * (1.0f / 256.0f) + LN_EPS);
        const f32x4 y = d * rstd * g + b;
        o.x = pk2(siluf_(y[0]), siluf_(y[1])); o.y = pk2(siluf_(y[2]), siluf_(y[3]));
      }
      *(u32x2*)(ab + tt * AROW + lane * 8) = o;
    }
  }
  __syncthreads();
  {
    const char* abp = ab + (lane & 31) * AROW + (lane >> 5) * 16;
    f32x16 a0 = zero16(), a1 = zero16();
#pragma unroll
    for (int s = 0; s < 16; ++s) {
      const bf16x8 af = *(const bf16x8*)(abp + s * 32);
      a0 = mfma32(bfr[s][0], af, a0); a1 = mfma32(bfr[s][1], af, a1);
    }
    const int i = lane & 31, hh = lane >> 5;
    if (i < ntok) {
      const int t = t0 + i;
      const bf16_t* zr = z + (size_t)t * ZLD + ZC_GB;
      bf16_t* ym = (bf16_t*)(p.ws + OFF_YMIX) + (size_t)t * 1024 + 256;
#pragma unroll
      for (int jb = 0; jb < 2; ++jb)
#pragma unroll
        for (int g = 0; g < 4; ++g) {
          const int n = w * 64 + jb * 32 + 8 * g + 4 * hh;
          const f32x4 bp = *(const f32x4*)(p.conv_b_pw + l * 256 + n + oz);
          const u32x2 gb = *(const u32x2*)(zr + n);
          const f32x16& a = jb ? a1 : a0;
          u32x2 o;
          o.x = pk2((a[4 * g] + bp[0]) * bflo(gb.x), (a[4 * g + 1] + bp[1]) * bfhi(gb.x));
          o.y = pk2((a[4 * g + 2] + bp[2]) * bflo(gb.y), (a[4 * g + 3] + bp[3]) * bfhi(gb.y));
          *(u32x2*)(ym + n) = o;
        }
    }
  }
  __syncthreads();
}

DI void phase_mix(const Params& p, int l, char* lds) {
  const int tx = otid();
  const bf16_t* z = (const bf16_t*)(p.ws + OFF_Z);
  const bf16_t* wuq = (const bf16_t*)(p.ws + OFF_WUQ) + (size_t)l * 768 * 384;
  const bf16_t* wukv = (const bf16_t*)(p.ws + OFF_WUKV) + (size_t)l * 1024 * 256;
  const bf16_t* lats = (const bf16_t*)(p.ws + OFF_LATS) + (size_t)l * SROWS * 256;
  const int G = gridDim.x, c = blockIdx.x;
  auto first = [&](int b) { const int r = c - (b % G); return r < 0 ? r + G : r; };
  int base = 0;
  {
    EpiQ e{(bf16_t*)(p.ws + OFF_H)};
    g256::phase(z + ZC_CQ, ZLD, wuq, 384, 384, TP, 768, first(base), lds, e);
    base += 384;
    EpiKp ek{(bf16_t*)(p.ws + OFF_KP)};
    g256::phase(z + ZC_CKV, ZLD, wukv, 256, 256, TP, 512, first(base), lds, ek);
    base += 256;
    EpiVt ev{(bf16_t*)(p.ws + OFF_VTP)};
    g256::phase(wukv + 512 * 256, 256, z + ZC_CKV, ZLD, 256, 512, TP, first(base), lds, ev);
    base += 256;
    EpiStore eks{(bf16_t*)(p.ws + OFF_KS), 512};
    g256::phase(lats, 256, wukv, 256, 256, SROWS, 512, first(base), lds, eks);
    base += 136;
    EpiVts evs{(bf16_t*)(p.ws + OFF_VTS)};
    g256::phase(wukv + 512 * 256, 256, lats, 256, 256, 512, SROWS, first(base), lds, evs);
    base += 132;
    for (int v = first(base); v < 3; v += G) gemm_tile8(z + ZC_CQ, ZLD, wuq, 384, 384, TP, v * 256, lds, e);
    base += 3;
  }
  const int half = tx >> 8, tid = tx & 255;
  char* hl = lds + half * 65536;
  for (int v = first(base); v < 516; v += G) conv_unit(p, l, v * 2 + half, hl, tid);
  base += 516;
  for (int v = first(base); v < 512; v += G) { const int u = v * 2 + half; gate_unit(p, l, u >> 2, u & 3, hl, tid); }
  base += 512;
  for (int v = first(base); v < 4; v += G) sgate_unit(p, l, v * 2 + half, tid);
}

constexpr int KROW = 208, VROWB = 144, KT_BYTES = 64 * KROW, ATT_STAGE = KT_BYTES + 64 * VROWB;

constexpr float ATT_RAISE = 24.0f;
DI void attn_tile_math(f32x16& s0, f32x16& s1, float& m, float& lsum, f32x16& o0, f32x16& o1, const bf16x8 (&vf)[2][2][2]) {
  if (__builtin_amdgcn_ballot_w64(m != 0.f) != 0) {
#pragma unroll
    for (int r = 0; r < 16; ++r) { s0[r] -= m; s1[r] -= m; }
  }
  int mi = max(__builtin_bit_cast(int, s0[0]), __builtin_bit_cast(int, s1[0]));
#pragma unroll
  for (int r = 1; r < 16; ++r) mi = max(mi, max(__builtin_bit_cast(int, s0[r]), __builtin_bit_cast(int, s1[r])));
  {
    typedef unsigned u2v __attribute__((ext_vector_type(2)));
    const u2v sw = __builtin_amdgcn_permlane32_swap((unsigned)mi, (unsigned)mi, false, false);
    mi = max((int)sw.x, (int)sw.y);
  }
  const bool up = mi > __builtin_bit_cast(int, ATT_RAISE);
  if (__builtin_amdgcn_ballot_w64(up) != 0) {
    const float delta = up ? __builtin_bit_cast(float, mi) : 0.f;
    const float alpha = __builtin_amdgcn_exp2f(-delta);
    m += delta; lsum *= alpha; o0 *= alpha; o1 *= alpha;
#pragma unroll
    for (int r = 0; r < 16; ++r) { s0[r] -= delta; s1[r] -= delta; }
  }
  float rs = 0.f;
#pragma unroll
  for (int r = 0; r < 16; ++r) { s0[r] = __builtin_amdgcn_exp2f(s0[r]); s1[r] = __builtin_amdgcn_exp2f(s1[r]); rs += s0[r] + s1[r]; }
  lsum += rs;
#pragma unroll
  for (int kb = 0; kb < 2; ++kb)
#pragma unroll
    for (int ks = 0; ks < 2; ++ks) {
      const f32x16& sv = kb ? s1 : s0;
      u32x4 pw;
      pw.x = pk2(sv[8 * ks + 0], sv[8 * ks + 1]); pw.y = pk2(sv[8 * ks + 2], sv[8 * ks + 3]);
      pw.z = pk2(sv[8 * ks + 4], sv[8 * ks + 5]); pw.w = pk2(sv[8 * ks + 6], sv[8 * ks + 7]);
      const bf16x8 pf = __builtin_bit_cast(bf16x8, pw);
      o0 = mfma32(vf[0][kb][ks], pf, o0); o1 = mfma32(vf[1][kb][ks], pf, o1);
    }
}
DI f32x16 splat16(float v) { f32x16 z; for (int i = 0; i < 16; ++i) z[i] = v; return z; }

DI void attn_unit(const Params& p, int b, int h, int qt, char* lds) {
  const int tx = otid();
  const int tid = tx, lane = tid & 63, w = __builtin_amdgcn_readfirstlane(tid >> 6);
  const bf16_t* z = (const bf16_t*)(p.ws + OFF_Z);
  const bf16_t* Q = (const bf16_t*)(p.ws + OFF_H);
  const bf16_t* Kp = (const bf16_t*)(p.ws + OFF_KP);
  const bf16_t* Vt = (const bf16_t*)(p.ws + OFF_VTP);
  const int nT = 2 * qt + 2, my_nkt = 4 * qt + 1 + (w >> 1);
  const size_t trow = (size_t)b * SEQ + qt * 256 + w * 32 + (lane & 31);
  bf16x8 qf[6];
#pragma unroll
  for (int s = 0; s < 6; ++s) qf[s] = *(const bf16x8*)(Q + trow * 768 + h * 96 + s * 16 + (lane >> 5) * 8);
  rope_qfrag(qf[4], qf[5], (const f32x2*)(p.ws + OFF_CS) + (size_t)(qt * 256 + w * 32 + (lane & 31)) * 16 + (lane >> 5) * 8);
  const bf16_t* kg0 = Kp + ((size_t)(b * 8 + h) * SEQ) * 64 + tid * 8;
  const bf16_t* kg1 = (const bf16_t*)(p.ws + OFF_KRP) + ((size_t)b * SEQ) * 32 + (tid & 255) * 8;
  constexpr size_t kst0 = 64 * 64, kst1 = 64 * 32, vst = 4096;
  const int klo0 = (tid >> 3) * KROW + (tid & 7) * 16, klo1 = ((tid & 255) >> 2) * KROW + (8 + (tid & 3)) * 16;
  const bool two = tid < 256;
  const bf16_t* vg = Vt + ((size_t)(b * 8 + h) * 256) * 4096 + tid * 8;
  const int vlo = KT_BYTES + (tid >> 3) * VROWB + (tid & 7) * 16;
  u32x4 rk0[2], rk1[2], rv[2];
  rk1[0] = rk1[1] = (u32x4){0u, 0u, 0u, 0u};
#define ATT_GLOAD(T) do { _Pragma("unroll") for (int sb = 0; sb < 2; ++sb) { const size_t kt_ = (size_t)(2 * (T) + sb); \
    rk0[sb] = *(const u32x4*)(kg0 + kt_ * kst0); if (two) rk1[sb] = *(const u32x4*)(kg1 + kt_ * kst1); rv[sb] = *(const u32x4*)(vg + kt_ * vst); } } while (0)
#define ATT_LSTORE(slot) do { _Pragma("unroll") for (int sb = 0; sb < 2; ++sb) { char* st_ = lds + ((slot) * 2 + sb) * ATT_STAGE; \
    *(u32x4*)(st_ + klo0) = rk0[sb]; if (two) *(u32x4*)(st_ + klo1) = rk1[sb]; *(u32x4*)(st_ + vlo) = rv[sb]; } } while (0)
  ATT_GLOAD(0);
  ATT_LSTORE(0);
  __syncthreads();
  if (w < 4) __builtin_amdgcn_s_setprio(2); else __builtin_amdgcn_s_setprio(0);
  f32x16 o0 = zero16(), o1 = zero16();
  float m = 0.f, lsum = 0.f;
  const int kfo = (lane & 31) * KROW + (lane >> 5) * 16;
  const int vfo = KT_BYTES + (lane & 31) * VROWB + (lane >> 5) * 16;
  for (int T = 0; T < nT; ++T) {
    if (T + 1 < nT) ATT_GLOAD(T + 1);
    __builtin_amdgcn_sched_barrier(0);
    if (2 * T < my_nkt) {
      const char* sta = lds + ((T & 1) * 2) * ATT_STAGE;
      const char* stb = sta + ATT_STAGE;
      const bool actb = 2 * T + 1 < my_nkt;
      bf16x8 kf0[6], kf1[6], vf[2][2][2];
#define LDKF(stp) do { _Pragma("unroll") for (int s = 0; s < 6; ++s) { kf0[s] = *(const bf16x8*)((stp) + kfo + s * 32); kf1[s] = *(const bf16x8*)((stp) + kfo + 32 * KROW + s * 32); } } while (0)
#define LDVF(stp) do { _Pragma("unroll") for (int db = 0; db < 2; ++db) _Pragma("unroll") for (int kb = 0; kb < 2; ++kb) _Pragma("unroll") for (int ks = 0; ks < 2; ++ks) \
    vf[db][kb][ks] = *(const bf16x8*)((stp) + vfo + db * 32 * VROWB + (32 * kb + 16 * ks) * 2); } while (0)
      LDKF(sta);
      f32x16 s0 = zero16(), s1 = zero16();
#pragma unroll
      for (int s = 0; s < 6; ++s) { s0 = mfma32(kf0[s], qf[s], s0); s1 = mfma32(kf1[s], qf[s], s1); }
      __builtin_amdgcn_sched_barrier(0);
      LDVF(sta);
      if (actb) { _Pragma("unroll") for (int s = 0; s < 6; ++s) kf0[s] = *(const bf16x8*)(stb + kfo + s * 32); }
      __builtin_amdgcn_sched_barrier(0);
      attn_tile_math(s0, s1, m, lsum, o0, o1, vf);
      if (actb) {
#pragma unroll
        for (int s = 0; s < 6; ++s) kf1[s] = *(const bf16x8*)(stb + kfo + 32 * KROW + s * 32);
        s0 = zero16(); s1 = zero16();
#pragma unroll
        for (int s = 0; s < 6; ++s) s0 = mfma32(kf0[s], qf[s], s0);
#pragma unroll
        for (int s = 0; s < 6; ++s) s1 = mfma32(kf1[s], qf[s], s1);
        LDVF(stb);
        attn_tile_math(s0, s1, m, lsum, o0, o1, vf);
      }
#undef LDKF
#undef LDVF
    }
    __builtin_amdgcn_sched_barrier(0);
    if (T + 1 < nT) ATT_LSTORE((T + 1) & 1);
    __syncthreads();
  }
#undef ATT_GLOAD
#undef ATT_LSTORE
  __builtin_amdgcn_s_setprio(0);
  lsum += __shfl_xor(lsum, 32);
  const float inv = 1.0f / lsum;
  const int hh = lane >> 5;
  const bf16_t* gc = z + trow * ZLD + ZC_GC + h * 64;
  bf16_t* ym = (bf16_t*)(p.ws + OFF_YMIX) + trow * 1024 + 512 + h * 64;
#pragma unroll
  for (int db = 0; db < 2; ++db)
#pragma unroll
    for (int g = 0; g < 4; ++g) {
      const int d = db * 32 + 8 * g + 4 * hh;
      const u32x2 gv = *(const u32x2*)(gc + d);
      const f32x16& o = db ? o1 : o0;
      u32x2 wv;
      wv.x = pk2(o[4 * g] * inv * bflo(gv.x), o[4 * g + 1] * inv * bfhi(gv.x));
      wv.y = pk2(o[4 * g + 2] * inv * bflo(gv.y), o[4 * g + 3] * inv * bfhi(gv.y));
      *(u32x2*)(ym + d) = wv;
    }
}

DI void sattn_unit(const Params& p, int l, int b, int h, char* lds) {
  const int tx = otid();
  const int tid = tx, lane = tid & 63, w = tid >> 6, hh = lane >> 5;
  const bf16_t* z = (const bf16_t*)(p.ws + OFF_Z);
  const bf16_t* Q = (const bf16_t*)(p.ws + OFF_H);
  const bf16_t* Ks = (const bf16_t*)(p.ws + OFF_KS) + (size_t)b * SKVP * 512 + h * 64;
  const bf16_t* krs = (const bf16_t*)(p.ws + OFF_KRS) + (size_t)(l * 8 + b) * SKVP * 32;
  const bf16_t* Vts = (const bf16_t*)(p.ws + OFF_VTS) + (size_t)(h * 64) * SROWS + (size_t)b * SKVP;
  const size_t trow = (size_t)TP + b * 16 + (lane & 15);
  bf16x8 qf[6];
#pragma unroll
  for (int s = 0; s < 6; ++s) qf[s] = *(const bf16x8*)(Q + trow * 768 + h * 96 + s * 16 + hh * 8);
  rope_qfrag(qf[4], qf[5], (const f32x2*)(p.ws + OFF_CS) + (size_t)(PAST + (lane & 15)) * 16 + hh * 8);
  f32x16 o0 = zero16(), o1 = zero16();
  float m = 0.f, lsum = 0.f;
  bf16x8 kf0[6], kf1[6];
#define SK_LOAD(kt_) do { const size_t key_ = (size_t)(kt_) * 64 + (lane & 31); _Pragma("unroll") for (int s = 0; s < 6; ++s) { \
    kf0[s] = s < 4 ? *(const bf16x8*)(Ks + key_ * 512 + s * 16 + hh * 8) : *(const bf16x8*)(krs + key_ * 32 + (s - 4) * 16 + hh * 8); \
    kf1[s] = s < 4 ? *(const bf16x8*)(Ks + (key_ + 32) * 512 + s * 16 + hh * 8) : *(const bf16x8*)(krs + (key_ + 32) * 32 + (s - 4) * 16 + hh * 8); } } while (0)
  SK_LOAD(w);
  for (int kt = w; kt < 33; kt += 8) {
    bf16x8 vf[2][2][2];
#pragma unroll
    for (int db = 0; db < 2; ++db)
#pragma unroll
      for (int kb = 0; kb < 2; ++kb)
#pragma unroll
        for (int ks = 0; ks < 2; ++ks) vf[db][kb][ks] = *(const bf16x8*)(Vts + (size_t)(db * 32 + (lane & 31)) * SROWS + kt * 64 + 32 * kb + 16 * ks + 8 * hh);
    f32x16 s0 = zero16(), s1 = zero16();
#pragma unroll
    for (int s = 0; s < 6; ++s) { s0 = mfma32(kf0[s], qf[s], s0); s1 = mfma32(kf1[s], qf[s], s1); }
    __builtin_amdgcn_sched_barrier(0);
    if (kt + 8 < 33) SK_LOAD(kt + 8);
    __builtin_amdgcn_sched_barrier(0);
    if (kt == 32) {
#pragma unroll
      for (int r = 8; r < 16; ++r) s0[r] = -1e30f;
      s1 = splat16(-1e30f);
    }
    attn_tile_math(s0, s1, m, lsum, o0, o1, vf);
  }
#undef SK_LOAD
  lsum += __shfl_xor(lsum, 32);
  float* Ow = (float*)lds;
  float* mw = Ow + 8 * 64 * 32;
  float* lw = mw + 8 * 32;
#pragma unroll
  for (int db = 0; db < 2; ++db)
#pragma unroll
    for (int r = 0; r < 16; ++r) {
      const int d = db * 32 + (r & 3) + 8 * (r >> 2) + 4 * hh;
      Ow[(w * 64 + d) * 32 + (lane & 31)] = db ? o1[r] : o0[r];
    }
  if (hh == 0) { mw[w * 32 + lane] = m; lw[w * 32 + lane] = lsum; }
  __syncthreads();
#pragma unroll
  for (int j = 0; j < 2; ++j) {
    const int idx = tid + 512 * j, q = idx & 15, d = idx >> 4;
    float M = mw[q];
#pragma unroll
    for (int ww = 1; ww < 8; ++ww) M = fmaxf(M, mw[ww * 32 + q]);
    float L = 0.f, O = 0.f;
#pragma unroll
    for (int ww = 0; ww < 8; ++ww) { const float sc = __builtin_amdgcn_exp2f(mw[ww * 32 + q] - M); L += lw[ww * 32 + q] * sc; O += Ow[(ww * 64 + d) * 32 + q] * sc; }
    const int t = TP + b * 16 + q;
    const float gcv = bf2f(z[(size_t)t * ZLD + ZC_GC + h * 64 + d]);
    ((bf16_t*)(p.ws + OFF_YMIX))[(size_t)t * 1024 + 512 + h * 64 + d] = f2bf(O / L * gcv);
  }
  __syncthreads();
}

DI void phase_attn(const Params& p, int l, char* lds) {
  const int G = gridDim.x;
  for (int u = blockIdx.x; u < 64; u += G) sattn_unit(p, l, u >> 3, u & 7, lds);
  int v0 = (int)blockIdx.x - (64 % G); if (v0 < 0) v0 += G;
  for (int pr = v0; pr < 512; pr += G) {
    const int bh = (pr & 7) + 8 * ((pr >> 8) & 1), q = (pr >> 3) & 31;
    attn_unit(p, bh >> 3, bh & 7, 63 - q, lds);
    attn_unit(p, bh >> 3, bh & 7, q, lds);
  }
}

template <int L>
struct EpiOut {
  static constexpr bool ROPE = false, TAGGED = false;
  const float* xa; const float* xb; float* r; const float* mod; const float* stats; const float* g0; const float* b0;
  DI void quad(int m, int n, f32x4 v) const {
    const float* gate = mod + (size_t)mod_row(m) * 3072 + 2048;
    const f32x4 gv = *(const f32x4*)(gate + n);
    f32x4 xv;
    if (L == 0) xv = *(const f32x4*)((m < TP ? xa + (size_t)m * 1024 : xb + (size_t)(m - TP) * 1024) + n);
    else {
      const f32x2 st = *(const f32x2*)(stats + (size_t)m * 2);
      xv = (*(const f32x4*)(r + (size_t)m * 1024 + n) - st.x) * st.y * *(const f32x4*)(g0 + n) + *(const f32x4*)(b0 + n);
    }
    f32x4 o;
    o[0] = ALPHA * xv[0] + gv[0] * v[0]; o[1] = ALPHA * xv[1] + gv[1] * v[1];
    o[2] = ALPHA * xv[2] + gv[2] * v[2]; o[3] = ALPHA * xv[3] + gv[3] * v[3];
    *(f32x4*)(r + (size_t)m * 1024 + n) = o;
  }
};
template <int L>
DI void phase_out(const Params& p, char* lds) {
  EpiOut<L> e;
  e.xa = p.x_prompt; e.xb = p.x_sample;
  e.r = p.out;
  e.mod = (const float*)(p.ws + OFF_MOD) + (size_t)L * 10 * 3072;
  e.stats = (const float*)(p.ws + OFF_STATS); e.g0 = p.post_ln_g; e.b0 = p.post_ln_b;
  const bf16_t* ym = (const bf16_t*)(p.ws + OFF_YMIX);
  const bf16_t* wt = (const bf16_t*)(p.ws + OFF_WOUT) + (size_t)L * 1024 * 1024;
  g256::phase(ym, 1024, wt, 1024, 1024, TP, 1024, blockIdx.x, lds, e);
  for (int v = blockIdx.x; v < 4; v += gridDim.x) gemm_tile8(ym, 1024, wt, 1024, 1024, TP, v * 256, lds, e);
}

#define XB_TMO      128
#define XB_XCNT(j)  (256  + 64 * (j))
#define XB_XSUB(j)  (1280 + 64 * (j))
#define XB_XGEN(j)  (2304 + 64 * (j))
#define XB_TOP      3328
#define XB_TOPGEN   3392
#define XCD_BAR_WORDS 3456
#define XB_SPIN_CAP (1u << 18)
#define XLAS __attribute__((address_space(3)))
DI unsigned xb_ld(unsigned* p) { return __hip_atomic_load(p, __ATOMIC_RELAXED, __HIP_MEMORY_SCOPE_AGENT); }
DI unsigned xb_add(unsigned* p, unsigned v) { return __hip_atomic_fetch_add(p, v, __ATOMIC_RELAXED, __HIP_MEMORY_SCOPE_AGENT); }
DI unsigned xb_xcc_id() { return (unsigned)__builtin_amdgcn_s_getreg((3 << 11) | 20) & 0xFu; }
#define XB_SPIN(cond, bar) do { unsigned _sp = 0; while (cond) { __builtin_amdgcn_s_sleep(1); \
    if ((++_sp & 255u) == 0u) { if (xb_ld(&(bar)[XB_TMO])) break; if (_sp > XB_SPIN_CAP) { atomicAdd(&(bar)[XB_TMO], 1u); break; } } } } while (0)
struct XcdBarrier { unsigned* bar; unsigned x; volatile XLAS unsigned* st; };
DI XcdBarrier xcd_barrier_post(unsigned* bar, volatile XLAS unsigned* st) {
  XcdBarrier b; b.bar = bar; b.x = xb_xcc_id(); b.st = st;
  if (threadIdx.x == 0) (void)xb_add(&bar[XB_XCNT(b.x)], 1u);
  return b;
}
DI void xcd_barrier_complete(unsigned* bar, unsigned x, unsigned& nloc, unsigned& nx) {
  const unsigned G = gridDim.x * gridDim.y * gridDim.z;
  unsigned sum, cnt, mine, sp = 0u;
  for (;;) {
    sum = 0u; cnt = 0u; mine = 0u;
#pragma unroll
    for (unsigned j = 0; j < 16; ++j) { const unsigned c = xb_ld(&bar[XB_XCNT(j)]); sum += c; cnt += (c > 0u) ? 1u : 0u; mine = (j == x) ? c : mine; }
    if (sum == G) break;
    __builtin_amdgcn_s_sleep(1);
    if ((++sp & 255u) == 0u) { if (xb_ld(&bar[XB_TMO])) break; if (sp > XB_SPIN_CAP) { atomicAdd(&bar[XB_TMO], 1u); break; } }
  }
  nloc = mine > 0u ? mine : 1u; nx = cnt > 0u ? cnt : 1u;
}
DI void xcd_barrier(const XcdBarrier& b) {
  asm volatile("s_waitcnt vmcnt(0)" ::: "memory");
  __syncthreads();
  if (threadIdx.x == 0) {
    unsigned* bar = b.bar;
    __builtin_amdgcn_s_waitcnt(0);
    unsigned nloc = b.st[0], nx = b.st[1];
    if (nloc == 0u) { xcd_barrier_complete(bar, b.x, nloc, nx); b.st[0] = nloc; b.st[1] = nx; }
    const unsigned old = xb_add(&bar[XB_XSUB(b.x)], 1u);
    const unsigned gen = old / nloc;
    if (old + 1u == (gen + 1u) * nloc) {
      __builtin_amdgcn_fence(__ATOMIC_RELEASE, "agent");
      asm volatile("s_waitcnt vmcnt(0)" ::: "memory");
      const unsigned og = xb_add(&bar[XB_TOP], 1u);
      const unsigned tg = og / nx;
      if (og + 1u == (tg + 1u) * nx) xb_add(&bar[XB_TOPGEN], 1u);
      else XB_SPIN(xb_ld(&bar[XB_TOPGEN]) == tg, bar);
      __builtin_amdgcn_fence(__ATOMIC_ACQUIRE, "agent");
      xb_add(&bar[XB_XGEN(b.x)], 1u);
      asm volatile("s_waitcnt vmcnt(0)" ::: "memory");
    } else {
      XB_SPIN(xb_ld(&bar[XB_XGEN(b.x)]) == gen, bar);
      __builtin_amdgcn_fence(__ATOMIC_ACQUIRE, "agent");
      asm volatile("s_waitcnt vmcnt(0)" ::: "memory");
    }
  }
  __syncthreads();
}

template <int L>
DI void layer_phases(const Params& p, char* lds, const XcdBarrier& xb) {
  phase_ln(p, L);
  xcd_barrier(xb);
  phase_zgemm(p, L, lds);
  xcd_barrier(xb);
  phase_rows(p, L);
  xcd_barrier(xb);
  phase_mix(p, L, lds);
  xcd_barrier(xb);
  phase_attn(p, L, lds);
  xcd_barrier(xb);
  phase_out<L>(p, lds);
  xcd_barrier(xb);
}

__global__ void __launch_bounds__(512, 2) fwd_megakernel(Params p) {
  __shared__ __attribute__((aligned(16))) char lds[LDS_BYTES];
  __shared__ uint4 xb_words;
  cg::grid_group grid = cg::this_grid();
  if (threadIdx.x == 0) xb_words = make_uint4(0u, 0u, 0u, 0u);
  __syncthreads();
  const XcdBarrier xb = xcd_barrier_post((unsigned*)(p.ws + OFF_BAR), (volatile XLAS unsigned*)&xb_words);
  grid.sync();
  phase_prep(p, lds);
  xcd_barrier(xb);
  layer_phases<0>(p, lds, xb);
  layer_phases<1>(p, lds, xb);
  phase_ln(p, 2);
}

extern "C" void kernel_launch(void* const* d_in, const int* in_sizes, int n_in, void* d_out, int out_size, void* d_ws, size_t ws_size, hipStream_t stream) {
  static int grid_blocks = 0;
  if (!grid_blocks) {
    int dev = 0, cus = 0, per_cu = 0;
    (void)hipGetDevice(&dev);
    (void)hipDeviceGetAttribute(&cus, hipDeviceAttributeMultiprocessorCount, dev);
    (void)hipOccupancyMaxActiveBlocksPerMultiprocessor(&per_cu, fwd_megakernel, NTH, 0);
    if (per_cu < 1) per_cu = 1;
    grid_blocks = cus;
  }
  if (ws_size < WS_NEED) { fprintf(stderr, "workspace too small: %zu < %zu\n", ws_size, (size_t)WS_NEED); return; }
  Params p{};
  const float** f = (const float**)&p;
  for (int i = 0; i < 27; ++i) f[i] = (const float*)d_in[i];
  p.out = (float*)d_out;
  p.ws = (char*)d_ws;
  void* args[] = {&p};
  (void)hipMemsetAsync((char*)d_ws + OFF_BAR, 0, XCD_BAR_WORDS * 4, stream);
  hipError_t e = hipLaunchCooperativeKernel((void*)fwd_megakernel, dim3(grid_blocks), dim3(NTH), args, 0, stream);
  if (e != hipSuccess) fprintf(stderr, "cooperative launch failed: %s (grid %d)\n", hipGetErrorString(e), grid_blocks);
}
```
